# Optimizing an MI355X kernel written in HIP

```python
import jax, jax.numpy as jnp
from jax import lax
import numpy as np

D_MODEL = 1024
BATCH = 4
SEQ = 4096
DEPTH = 1
DEC_BATCH = 32
DEC_SEQ = 2048
PAST_LEN = 128

HEAD_DIM = 64
N_HEADS = D_MODEL // HEAD_DIM
NA_HEADS = N_HEADS // 2
DIL_HEADS = N_HEADS - NA_HEADS
NA_WIDTH = NA_HEADS * HEAD_DIM
DIL_WIDTH = DIL_HEADS * HEAD_DIM
QKV_WIDTH = 3 * (NA_WIDTH + DIL_WIDTH)
D_FF = -(-8 * D_MODEL // (3 * 256)) * 256
GRID_W = 64
NA_ROWS = 8
NA_COLS = 16
NA_KEY_COLS = 2 * NA_COLS
DIL_PATTERNS = ((128, 1), (512, 4), (2048, 16))
RMS_EPS = 1e-6
NEG = -1e30

kernel_name = "hymba_style_natten_dilated_encoder"


def rms_norm(x, g):
    xf = x.astype(jnp.float32)
    y = xf * lax.rsqrt(jnp.mean(xf * xf, axis=-1, keepdims=True) + RMS_EPS)
    return (y * g.astype(jnp.float32)).astype(x.dtype)


def alibi_slopes(n):
    return np.array([2.0 ** (-8.0 * (i + 1) / n) for i in range(n)], dtype=np.float32)


def neighbourhood_attention(q, k, v, rpb):
    b, t, h, dh = q.shape
    rows = t // GRID_W
    kh = min(NA_ROWS, rows)
    nblk = GRID_W // NA_COLS
    qcol = np.arange(GRID_W).reshape(nblk, NA_COLS)
    kstart = np.clip(np.arange(nblk) * NA_COLS - NA_COLS // 2, 0, GRID_W - NA_KEY_COLS)
    kcol = kstart[:, None] + np.arange(NA_KEY_COLS)
    wstart = np.clip(qcol - NA_COLS // 2, 0, GRID_W - NA_COLS)
    kc3 = kcol[:, None, :]
    col_ok = (kc3 >= wstart[..., None]) & (kc3 < wstart[..., None] + NA_COLS)
    rel_c_idx = np.clip(kc3 - qcol[..., None] + NA_COLS - 1, 0, 2 * NA_COLS - 2)
    col_bias = rpb.astype(jnp.float32)[:, :, rel_c_idx]
    mask = jnp.asarray(col_ok)[:, None, :, None, :]

    qg = (q * (dh ** -0.5)).reshape(b, rows, nblk, NA_COLS, h, dh).transpose(1, 0, 2, 3, 4, 5)
    kg = k.reshape(b, rows, GRID_W, h, dh)[:, :, kcol]
    vg = v.reshape(b, rows, GRID_W, h, dh)[:, :, kcol]

    def row_fn(args):
        r, q_r = args
        rs = jnp.clip(r - kh // 2, 0, rows - kh)
        k_r = lax.dynamic_slice_in_dim(kg, rs, kh, axis=1)
        v_r = lax.dynamic_slice_in_dim(vg, rs, kh, axis=1)
        roff = rs + jnp.arange(kh) - r + NA_ROWS - 1
        bias = col_bias[:, roff].transpose(2, 0, 3, 1, 4)
        s = jnp.einsum('bnqhd,bknjhd->bnhqkj', q_r, k_r).astype(jnp.float32)
        s = jnp.where(mask, s + bias, NEG)
        p = jax.nn.softmax(s, axis=(-2, -1))
        o = jnp.einsum('bnhqkj,bknjhd->bnqhd', p.astype(v.dtype), v_r)
        return o.reshape(b, GRID_W, h, dh)

    out = lax.map(row_fn, (jnp.arange(rows), qg))
    return out.transpose(1, 0, 2, 3, 4).reshape(b, t, h, dh)


def dilated_branch(q, k, v, slopes, window, dilation):
    b, t, h, dh = q.shape
    half = window // (2 * dilation)
    L = t // dilation
    c = half
    nb = -(-L // c)
    lp = nb * c

    def phase(x):
        return x.reshape(b, L, dilation, h, dh).transpose(0, 2, 1, 3, 4)

    def band(x):
        xp = jnp.pad(phase(x), ((0, 0), (0, 0), (c, lp - L + c), (0, 0), (0, 0)))
        xp = xp.reshape(b, dilation, nb + 2, c, h, dh)
        return jnp.concatenate([xp[:, :, :-2], xp[:, :, 1:-1], xp[:, :, 2:]], axis=3)

    qp = jnp.pad(phase(q * (dh ** -0.5)), ((0, 0), (0, 0), (0, lp - L), (0, 0), (0, 0)))
    qp = qp.reshape(b, dilation, nb, c, h, dh)
    kb, vb = band(k), band(v)
    diff = np.arange(3 * c)[None, :] - c - np.arange(c)[:, None]
    lk = np.arange(nb)[:, None] * c - c + np.arange(3 * c)[None, :]
    valid = (np.abs(diff)[None] <= half) & (lk[:, None, :] >= 0) & (lk[:, None, :] < L)
    bias = -slopes[:, None, None] * jnp.asarray((dilation * np.abs(diff)).astype(np.float32))
    s = jnp.einsum('bpnqhd,bpnkhd->bpnhqk', qp, kb).astype(jnp.float32)
    s = jnp.where(jnp.asarray(valid)[:, None], s + bias, NEG)
    m = s.max(-1)
    e = jnp.exp(s - m[..., None])
    den = e.sum(-1)
    num = jnp.einsum('bpnhqk,bpnkhd->bpnqhd', e, vb.astype(jnp.float32))

    def unphase(x):
        x = x.reshape((b, dilation, lp) + x.shape[4:])[:, :, :L]
        x = jnp.swapaxes(x, 1, 2)
        return x.reshape((b, t) + x.shape[3:])

    return (unphase(m.transpose(0, 1, 2, 4, 3)), unphase(num), unphase(den.transpose(0, 1, 2, 4, 3)))


def dilated_attention(q, k, v, slopes):
    branches = [dilated_branch(q, k, v, slopes, w, d) for (w, d) in DIL_PATTERNS]
    m_all = jnp.stack([br[0] for br in branches])
    wts = jnp.exp(m_all - m_all.max(0))
    num = sum(wts[i][..., None] * branches[i][1] for i in range(len(branches)))
    den = sum(wts[i] * branches[i][2] for i in range(len(branches)))
    return num / den[..., None]


def encoder_layer(x, w_in, rpb, g_attn, g_na, g_dil, w_out, g_ffn, w_gate, w_up, w_down):
    b, t, _ = x.shape
    hn = rms_norm(x, g_attn)
    proj = hn @ w_in
    qa, ka, va, qd, kd, vd = jnp.split(proj, 6, axis=-1)
    heads = lambda z: z.reshape(b, t, -1, HEAD_DIM)
    slopes = jnp.asarray(alibi_slopes(DIL_HEADS))
    oa = neighbourhood_attention(heads(qa), heads(ka), heads(va), rpb).reshape(b, t, NA_WIDTH)
    od = dilated_attention(heads(qd), heads(kd), heads(vd), slopes).astype(x.dtype).reshape(b, t, DIL_WIDTH)
    mix = jnp.concatenate([rms_norm(oa, g_na), rms_norm(od, g_dil)], axis=-1)
    x = x + mix @ w_out
    hn = rms_norm(x, g_ffn)
    return x + (jax.nn.silu(hn @ w_gate) * (hn @ w_up)) @ w_down


def setup_inputs(seed: int = 0) -> dict:
    key = jax.random.key(seed)
    ks = jax.random.split(key, 14)
    nrm = lambda k_, shp, sc: jax.random.normal(k_, shp, jnp.float32) * sc
    gain = lambda k_, n: 1.0 + 0.01 * jax.random.normal(k_, (DEPTH, n), jnp.float32)
    return {
        "x_prompt": jax.random.normal(ks[0], (BATCH, SEQ, D_MODEL), jnp.float32),
        "x_sample": jax.random.normal(ks[1], (DEC_BATCH, DEC_SEQ, D_MODEL), jnp.float32),
        "w_in": nrm(ks[2], (DEPTH, D_MODEL, QKV_WIDTH), D_MODEL ** -0.5),
        "rpb": nrm(ks[3], (DEPTH, NA_HEADS, 2 * NA_ROWS - 1, 2 * NA_COLS - 1), 0.02),
        "g_attn": gain(ks[4], D_MODEL),
        "g_na": gain(ks[5], NA_WIDTH),
        "g_dil": gain(ks[6], DIL_WIDTH),
        "w_out": nrm(ks[7], (DEPTH, D_MODEL, D_MODEL), D_MODEL ** -0.5),
        "g_ffn": gain(ks[8], D_MODEL),
        "w_gate": nrm(ks[9], (DEPTH, D_MODEL, D_FF), D_MODEL ** -0.5),
        "w_up": nrm(ks[10], (DEPTH, D_MODEL, D_FF), D_MODEL ** -0.5),
        "w_down": nrm(ks[11], (DEPTH, D_FF, D_MODEL), D_FF ** -0.5),
        "g_final": 1.0 + 0.01 * jax.random.normal(ks[12], (D_MODEL,), jnp.float32),
    }


def reference(x_prompt, x_sample, w_in, rpb, g_attn, g_na, g_dil, w_out, g_ffn, w_gate, w_up, w_down, g_final):
    def trunk(x):
        for l in range(DEPTH):
            x = encoder_layer(x, w_in[l], rpb[l], g_attn[l], g_na[l], g_dil[l], w_out[l],
                              g_ffn[l], w_gate[l], w_up[l], w_down[l])
        return rms_norm(x, g_final)

    y_prompt = trunk(x_prompt)
    y_sample = trunk(x_sample)
    return (y_prompt, y_sample)
```

```cpp
#include <hip/hip_runtime.h>
#include <hip/hip_cooperative_groups.h>
#include <cstdio>
#include <cstdint>
namespace cg = cooperative_groups;
namespace pg8 {
#define PG8_LAS __attribute__((address_space(3)))
typedef unsigned short bf16_t;
typedef short bf16x8 __attribute__((ext_vector_type(8)));
typedef float f32x4 __attribute__((ext_vector_type(4)));
typedef unsigned u32x4 __attribute__((ext_vector_type(4)));
constexpr int BM = 256, BK = 64, HALF = 128, HTB = HALF * BK * 2  , STAGE_BYTES = 8 * HTB, NXCD = 8, WGM = 8;

__host__ __device__ __forceinline__ int lds_byte(int r, int c) { const int st = (r >> 4) * 2 + (c >> 5), rr = r & 15, cc = c & 31, ob = rr * 64 + cc * 2; return st * 1024 + (ob ^ (((ob >> 9) & 1) << 5)); }
__host__ __device__ __forceinline__ void stage_rc(int b, int& R, int& C) { const int st = b / 1024, sb = b % 1024, swz = sb ^ (((sb >> 9) & 1) << 5); R = (st >> 1) * 16 + swz / 64; C = (st & 1) * 32 + (swz % 64) / 2; }
__host__ __device__ __forceinline__ int perm32(int rho) { const int n = rho >> 4, i = rho & 15; return 8 * (i >> 2) + 4 * n + (i & 3); }

struct Unit { int pm, pn; };
struct Gemm { const bf16_t* A; const bf16_t* Bt; int M, N, K; };

struct StaticOrder {
    int nM, nN, nwg, G, c;
    __host__ __device__ void init(int M, int N, int G_, int c_) { nM = M / BM; nN = N / BM; nwg = nM * nN; G = G_; c = c_; }
    __host__ __device__ bool next(int i, Unit& u) const {
        const long L = (long)i * G + c; if (L >= nwg) return false;
        int wgid = (int)L; { const int q = nwg / NXCD, r = nwg % NXCD, xcd = wgid % NXCD, off = wgid / NXCD; wgid = (xcd < r ? xcd * (q + 1) : r * (q + 1) + (xcd - r) * q) + off; }
        const int nig = WGM * nN, gid = wgid / nig, fm = gid * WGM, gsz = (nM - fm) < WGM ? (nM - fm) : WGM;
        u.pm = fm + ((wgid % nig) % gsz); u.pn = (wgid % nig) / gsz; return true;
    }
    __device__ __forceinline__ void a_ready(const Unit&) const {}
    __device__ __forceinline__ void done(const Unit&) const {}
};


typedef float f32x2_t __attribute__((ext_vector_type(2))); typedef __bf16 bf16x2_t __attribute__((ext_vector_type(2)));
__device__ __forceinline__ unsigned cvt_pk_bf16(float lo, float hi) { const f32x2_t v = {lo, hi}; const bf16x2_t b = __builtin_convertvector(v, bf16x2_t); return __builtin_bit_cast(unsigned, b); }
typedef unsigned u32x2 __attribute__((ext_vector_type(2)));

struct EpiStoreBf16 {
    static constexpr bool PERM = true, AFTER_DRAIN = false;
    bf16_t* O; int ldc;
    __device__ __forceinline__ void operator()(const f32x4 (&acc)[2][2][4][2], const Unit& u, int wr, int wc, int fr, int fq) const {
        const int row0 = u.pm * BM + wr * 64 + fr, col0 = u.pn * BM + wc * 32 + 8 * fq;
#pragma unroll
        for (int ai = 0; ai < 2; ++ai)
#pragma unroll
            for (int m = 0; m < 4; ++m) { bf16_t* rowp = O + (size_t)(row0 + ai * HALF + m * 16) * ldc + col0;
#pragma unroll
                for (int bj = 0; bj < 2; ++bj) { const f32x4 v0 = acc[ai][bj][m][0], v1 = acc[ai][bj][m][1];
                    u32x4 w; w.x = cvt_pk_bf16(v0[0], v0[1]); w.y = cvt_pk_bf16(v0[2], v0[3]); w.z = cvt_pk_bf16(v1[0], v1[1]); w.w = cvt_pk_bf16(v1[2], v1[3]);
                    *(u32x4*)(rowp + bj * HALF) = w; } }
    }
};

template <bool FIRST> struct EpiResid {
    static constexpr bool PERM = false, AFTER_DRAIN = false;
    const float* srow; const float* ginv; int split; const bf16_t* rb; bf16_t* ob; float* ss;
    __device__ __forceinline__ void operator()(const f32x4 (&acc)[2][2][4][2], const Unit& u, int wr, int wc, int fr, int fq) const {
        const int row0 = u.pm * BM + wr * 64 + fr, col0 = u.pn * BM + wc * 32 + 4 * fq;
        f32x4 gi[2][2];
#pragma unroll
        for (int bj = 0; bj < 2; ++bj)
#pragma unroll
            for (int n = 0; n < 2; ++n) gi[bj][n] = FIRST ? *(const f32x4*)(ginv + col0 + bj * HALF + n * 16) : (f32x4){1.f, 1.f, 1.f, 1.f};
#pragma unroll
        for (int ai = 0; ai < 2; ++ai)
#pragma unroll
            for (int m = 0; m < 4; ++m) { const int row = row0 + ai * HALF + m * 16;
                const bf16_t* rbp = rb + (size_t)row * 1024 + col0;
                const float sr = FIRST ? srow[row] : 1.0f;
                bf16_t* op = ob + (size_t)row * 1024 + col0;
                float s = 0.f;
#pragma unroll
                for (int bj = 0; bj < 2; ++bj)
#pragma unroll
                    for (int n = 0; n < 2; ++n) { const int c = bj * HALF + n * 16; f32x4 r;
                        { const u32x2 w = *(const u32x2*)(rbp + c); r = (f32x4){__uint_as_float(w.x << 16), __uint_as_float(w.x & 0xffff0000u), __uint_as_float(w.y << 16), __uint_as_float(w.y & 0xffff0000u)}; }
                        if (FIRST) r = r * gi[bj][n] * sr;
                        const f32x4 v = r + acc[ai][bj][m][n];
                        u32x2 w; w.x = cvt_pk_bf16(v[0], v[1]); w.y = cvt_pk_bf16(v[2], v[3]); *(u32x2*)(op + c) = w;
                        s += (v[0] * v[0] + v[1] * v[1]) + (v[2] * v[2] + v[3] * v[3]); }
                s += __shfl_xor(s, 16); s += __shfl_xor(s, 32); if (fq == 0) ss[(size_t)row * 16 + u.pn * 4 + wc] = s; }
    }
};

struct EpiSwiglu {
    static constexpr bool PERM = true, AFTER_DRAIN = false;
    bf16_t* H; int ldh; const float* ss;
    __device__ __forceinline__ void operator()(const f32x4 (&acc)[2][2][4][2], const Unit& u, int wr, int wc, int fr, int fq) const {
        const int row0 = u.pm * BM + wr * 64 + fr, f0 = u.pn * HALF + wc * 32 + 8 * fq;
#pragma unroll
        for (int ai = 0; ai < 2; ++ai)
#pragma unroll
            for (int m = 0; m < 4; ++m) { const int row = row0 + ai * HALF + m * 16;
                const f32x4* sp = (const f32x4*)(ss + (size_t)row * 16); const f32x4 a = sp[0], b = sp[1], c = sp[2], d = sp[3];
                const float tot = ((a[0] + a[1]) + (a[2] + a[3])) + ((b[0] + b[1]) + (b[2] + b[3])) + ((c[0] + c[1]) + (c[2] + c[3])) + ((d[0] + d[1]) + (d[2] + d[3]));
                const float rinv = 1.0f / sqrtf(tot * (1.0f / 1024.0f) + 1e-6f);
                float hv[8];
#pragma unroll
                for (int n = 0; n < 2; ++n)
#pragma unroll
                    for (int i = 0; i < 4; ++i) { const float g = acc[ai][0][m][n][i] * rinv, up = acc[ai][1][m][n][i] * rinv;
                        const float e = __builtin_amdgcn_exp2f(g * -1.4426950408889634f); hv[n * 4 + i] = g * __builtin_amdgcn_rcpf(1.0f + e) * up; }
                u32x4 w; w.x = cvt_pk_bf16(hv[0], hv[1]); w.y = cvt_pk_bf16(hv[2], hv[3]); w.z = cvt_pk_bf16(hv[4], hv[5]); w.w = cvt_pk_bf16(hv[6], hv[7]);
                *(u32x4*)(H + (size_t)row * ldh + f0) = w; }
    }
};

template <class Epi, class Sched, bool ALIGN_EPI = false, bool SP2 = false>
__device__ __forceinline__ void gemm_phase(PG8_LAS unsigned char* lds, const Gemm g, const Sched& S, const Epi& E, const int wid_in) {
    int lane_ = __builtin_amdgcn_mbcnt_hi(~0u, __builtin_amdgcn_mbcnt_lo(~0u, 0u)); asm volatile("" : "+v"(lane_)); const int wid = wid_in, lane = lane_ & 63, tid = wid * 64 + lane, wr = wid >> 2, wc = wid & 3, fr = lane & 15, fq = lane >> 4;
    const int K = g.K, nt = K / BK;
    unsigned voffA[2], voffB[2];
#pragma unroll
    for (int i = 0; i < 2; ++i) { int R, C; stage_rc(tid * 16 + i * 8192, R, C); const int Rb = Epi::PERM ? ((R & ~31) + perm32(R & 31)) : R;
        voffA[i] = (unsigned)(R * K + C) * 2u; voffB[i] = (unsigned)(Rb * K + C) * 2u; }
    const size_t kstep = (size_t)(BK * 2);
    const size_t hstep = (size_t)HALF * K * 2;
    const size_t tstep = 2 * hstep;
    const unsigned ldsw = (unsigned)wid * 1024u;
    const int aoff = lds_byte(wr * 64 + fr, fq * 8), boff = lds_byte(wc * 32 + fr, fq * 8);
#define PG8_SA(b, h) (((b) * 2 + (h)) * HTB)
#define PG8_SB(b, h) ((4 + (b) * 2 + (h)) * HTB)
#define PG8_STAGE(bufoff, gbase, voff) do { _Pragma("unroll") for (int _i = 0; _i < 2; ++_i) \
        __builtin_amdgcn_global_load_lds((const unsigned*)((const char*)(gbase) + (voff)[_i]), (PG8_LAS unsigned*)(lds + (bufoff) + ldsw + _i * 8192), 16, 0, 0); } while (0)
#define PG8_LDA(dst, b, h) do { _Pragma("unroll") for (int m = 0; m < 4; ++m) _Pragma("unroll") for (int k = 0; k < 2; ++k) dst[m][k] = *(const PG8_LAS bf16x8*)(lds + PG8_SA(b, h) + aoff + m * 2048 + k * 1024); } while (0)
#define PG8_LDB(dst, b, h) do { _Pragma("unroll") for (int n = 0; n < 2; ++n) _Pragma("unroll") for (int k = 0; k < 2; ++k) dst[n][k] = *(const PG8_LAS bf16x8*)(lds + PG8_SB(b, h) + boff + n * 2048 + k * 1024); } while (0)
#define PG8_MMA(ai, bj, At, Bt) do { __builtin_amdgcn_s_setprio(1); _Pragma("unroll") for (int m = 0; m < 4; ++m) _Pragma("unroll") for (int n = 0; n < 2; ++n) _Pragma("unroll") for (int k = 0; k < 2; ++k) \
        acc[ai][bj][m][n] = __builtin_amdgcn_mfma_f32_16x16x32_bf16(Bt[n][k], At[m][k], acc[ai][bj][m][n], 0, 0, 0); __builtin_amdgcn_s_setprio(0); } while (0)
#define PG8_WAIT_V(n) asm volatile("s_waitcnt vmcnt(" #n ")" ::: "memory")
#define PG8_WAIT_L(n) asm volatile("s_waitcnt lgkmcnt(" #n ")" ::: "memory")
#define PG8_BAR __builtin_amdgcn_s_barrier()
#define PG8_SCHED __builtin_amdgcn_sched_barrier(0)
    Unit cur, nxt; int ui = 0;
    if (!S.next(0, cur)) return;
    f32x4 acc[2][2][4][2];
#pragma unroll
    for (int a = 0; a < 2; ++a)
#pragma unroll
        for (int b = 0; b < 2; ++b)
#pragma unroll
            for (int m = 0; m < 4; ++m)
#pragma unroll
                for (int n = 0; n < 2; ++n) acc[a][b][m][n] = (f32x4){0.f, 0.f, 0.f, 0.f};
    bf16x8 At[4][2], B0[2][2], B1[2][2];
    const char* cA = (const char*)g.A + (size_t)cur.pm * tstep; const char* cB = (const char*)g.Bt + (size_t)cur.pn * tstep;
    S.a_ready(cur);
    if constexpr (SP2) {
        PG8_STAGE(PG8_SB(0, 0), cB, voffB); PG8_STAGE(PG8_SB(0, 1), cB + hstep, voffB); PG8_STAGE(PG8_SA(0, 0), cA, voffA); PG8_STAGE(PG8_SA(0, 1), cA + hstep, voffA);
        if (wr == 1) PG8_BAR;
        PG8_WAIT_V(2); PG8_BAR;
        PG8_STAGE(PG8_SB(1, 0), cB + kstep, voffB); PG8_STAGE(PG8_SA(1, 0), cA + kstep, voffA); PG8_STAGE(PG8_SB(1, 1), cB + hstep + kstep, voffB);
        PG8_WAIT_V(6); PG8_BAR;
    } else {
        PG8_STAGE(PG8_SB(0, 0), cB, voffB); PG8_STAGE(PG8_SA(0, 0), cA, voffA); PG8_STAGE(PG8_SB(0, 1), cB + hstep, voffB); PG8_STAGE(PG8_SA(0, 1), cA + hstep, voffA);
        if (wr == 1) PG8_BAR;
        PG8_WAIT_V(4); PG8_BAR;
        PG8_STAGE(PG8_SB(1, 0), cB + kstep, voffB); PG8_STAGE(PG8_SA(1, 0), cA + kstep, voffA); PG8_STAGE(PG8_SB(1, 1), cB + hstep + kstep, voffB);
        PG8_WAIT_V(6); PG8_BAR;
    }
    for (;;) {
        const bool has_next = S.next(ui + 1, nxt);
        const char* nA = has_next ? (const char*)g.A + (size_t)nxt.pm * tstep : cA; const char* nB = has_next ? (const char*)g.Bt + (size_t)nxt.pn * tstep : cB;
        for (int t = 0; t < nt; t += 2) {
            const bool last = (t == nt - 2);
            const char* a1 = cA + (size_t)(t + 1) * kstep;
            const char* a2 = last ? nA : cA + (size_t)(t + 2) * kstep; const char* b2 = last ? nB : cB + (size_t)(t + 2) * kstep;
            const char* a3 = a2 + kstep; const char* b3 = b2 + kstep;
            if (last && has_next) S.a_ready(nxt);
            if constexpr (SP2) {
            PG8_LDB(B0, 0, 0); PG8_LDB(B1, 0, 1); PG8_SCHED; PG8_LDA(At, 0, 0); PG8_STAGE(PG8_SA(1, 1), a1 + hstep, voffA);
            PG8_WAIT_V(8); PG8_WAIT_L(0); PG8_BAR; PG8_MMA(0, 0, At, B0); PG8_MMA(0, 1, At, B1); PG8_BAR; PG8_SCHED;
            PG8_LDA(At, 0, 1); PG8_STAGE(PG8_SB(0, 0), b2, voffB); PG8_STAGE(PG8_SB(0, 1), b2 + hstep, voffB); PG8_STAGE(PG8_SA(0, 0), a2, voffA);
            PG8_WAIT_V(8); PG8_WAIT_L(0); PG8_BAR; PG8_MMA(1, 0, At, B0); PG8_MMA(1, 1, At, B1); PG8_BAR; PG8_SCHED;
            PG8_LDB(B0, 1, 0); PG8_LDB(B1, 1, 1); PG8_SCHED; PG8_LDA(At, 1, 0); PG8_STAGE(PG8_SA(0, 1), a2 + hstep, voffA);
            PG8_WAIT_V(8); PG8_WAIT_L(0); PG8_BAR; PG8_MMA(0, 0, At, B0); PG8_MMA(0, 1, At, B1); PG8_BAR; PG8_SCHED;
            PG8_LDA(At, 1, 1); PG8_STAGE(PG8_SB(1, 0), b3, voffB); PG8_STAGE(PG8_SB(1, 1), b3 + hstep, voffB); PG8_STAGE(PG8_SA(1, 0), a3, voffA);
            PG8_WAIT_V(8); PG8_WAIT_L(0); PG8_BAR; PG8_MMA(1, 0, At, B0); PG8_MMA(1, 1, At, B1); PG8_BAR; PG8_SCHED;
            } else {
            PG8_LDB(B0, 0, 0); PG8_SCHED; PG8_LDA(At, 0, 0); PG8_STAGE(PG8_SA(1, 1), a1 + hstep, voffA);
            PG8_WAIT_L(8); PG8_BAR; PG8_WAIT_L(0); PG8_MMA(0, 0, At, B0); PG8_BAR; PG8_SCHED;
            PG8_LDB(B1, 0, 1); PG8_STAGE(PG8_SB(0, 0), b2, voffB);
            PG8_BAR; PG8_WAIT_L(0); PG8_MMA(0, 1, At, B1); PG8_BAR;
            PG8_LDA(At, 0, 1); PG8_STAGE(PG8_SA(0, 0), a2, voffA);
            PG8_BAR; PG8_WAIT_L(0); PG8_MMA(1, 0, At, B0); PG8_BAR; PG8_SCHED;
            PG8_STAGE(PG8_SB(0, 1), b2 + hstep, voffB);
            PG8_WAIT_V(6); PG8_BAR; PG8_MMA(1, 1, At, B1); PG8_BAR;
            PG8_LDB(B0, 1, 0); PG8_SCHED; PG8_LDA(At, 1, 0); PG8_STAGE(PG8_SA(0, 1), a2 + hstep, voffA);
            PG8_WAIT_L(8); PG8_BAR; PG8_WAIT_L(0); PG8_MMA(0, 0, At, B0); PG8_BAR; PG8_SCHED;
            PG8_LDB(B1, 1, 1); PG8_STAGE(PG8_SB(1, 0), b3, voffB);
            PG8_BAR; PG8_WAIT_L(0); PG8_MMA(0, 1, At, B1); PG8_BAR;
            PG8_LDA(At, 1, 1); PG8_STAGE(PG8_SA(1, 0), a3, voffA);
            PG8_BAR; PG8_WAIT_L(0); PG8_MMA(1, 0, At, B0); PG8_BAR; PG8_SCHED;
            PG8_STAGE(PG8_SB(1, 1), b3 + hstep, voffB);
            PG8_WAIT_V(6); PG8_BAR; PG8_MMA(1, 1, At, B1); PG8_BAR;
            }
        }
        if constexpr (ALIGN_EPI) { if (wr == 0) PG8_BAR; }
        if constexpr (!Epi::AFTER_DRAIN) { E(acc, cur, wr, wc, fr, fq); S.done(cur); }
        if (!has_next) break;
#pragma unroll
        for (int a = 0; a < 2; ++a)
#pragma unroll
            for (int b = 0; b < 2; ++b)
#pragma unroll
                for (int m = 0; m < 4; ++m)
#pragma unroll
                    for (int n = 0; n < 2; ++n) acc[a][b][m][n] = (f32x4){0.f, 0.f, 0.f, 0.f};
        cur = nxt; cA = nA; cB = nB; ++ui;
        if constexpr (ALIGN_EPI) { if (wr == 1) PG8_BAR; }
    }
    PG8_WAIT_V(0);
    if constexpr (!ALIGN_EPI) { if (wr == 0) PG8_BAR; }
    PG8_BAR;
    if constexpr (Epi::AFTER_DRAIN) { E.fused(acc, cur, wr, wc, fr, fq, lds, wid, lane); S.done(cur); }
#undef PG8_SA
#undef PG8_SB
#undef PG8_STAGE
#undef PG8_LDA
#undef PG8_LDB
#undef PG8_MMA
#undef PG8_WAIT_V
#undef PG8_WAIT_L
#undef PG8_BAR
#undef PG8_SCHED
}
}

constexpr int DM = 1024, NPROMPT = 4 * 4096, NSAMPLE = 32 * 2048, MROWS = NPROMPT + NSAMPLE;
constexpr int QKVW = 3072, DFF = 2816, GUW = 2 * DFF;
constexpr float LOG2E = 1.4426950408889634f, RMS_EPS = 1e-6f;
constexpr size_t MiB = 1u << 20;
constexpr size_t WS_WIN = 2 * MiB, WS_WO = 8 * MiB, WS_WGU = 10 * MiB, WS_WD = 22 * MiB, WS_SS = 28 * MiB;
constexpr size_t WS_XN = 34 * MiB;
constexpr size_t WS_MIX = 194 * MiB;
constexpr size_t WS_QKV = 354 * MiB;
constexpr size_t WS_SROW = 1 * MiB, WS_GINV = 1 * MiB + 512 * 1024;
constexpr size_t WS_END = 834 * MiB;
constexpr int RING_BYTES = 131072, LDS_BYTES = 147456;

#define LAS __attribute__((address_space(3)))
typedef unsigned short bf16_t;
typedef short bf16x8 __attribute__((ext_vector_type(8)));
typedef short v4i16 __attribute__((ext_vector_type(4)));
typedef float f32x4 __attribute__((ext_vector_type(4)));
typedef unsigned u32x4 __attribute__((ext_vector_type(4)));
typedef unsigned u32x2 __attribute__((ext_vector_type(2)));

typedef float f32x2_t __attribute__((ext_vector_type(2))); typedef __bf16 bf16x2_t __attribute__((ext_vector_type(2)));
__device__ __forceinline__ unsigned cvtpk(float lo, float hi) { const f32x2_t v = {lo, hi}; const bf16x2_t b = __builtin_convertvector(v, bf16x2_t); return __builtin_bit_cast(unsigned, b); }
__device__ __forceinline__ float wave_sum(float v) {
#pragma unroll
    for (int o = 1; o < 64; o <<= 1) v += __shfl_xor(v, o);
    return v;
}

namespace att {
constexpr int VRS = 160, VBUF = 32 * VRS, KRS = 144, KBUF = 32 * KRS, WBUF = VBUF + KBUF;
constexpr int LDS_TAB = 8 * WBUF + 256, LDS_EXCH = 98304, LDS_GAIN = 106496;
constexpr float RESCALE_THR = 6.0f;
constexpr float M_INIT = -4096.f;
typedef float f32x2 __attribute__((ext_vector_type(2)));
struct Tile { f32x4 o[4]; float la; float m; };
__device__ __forceinline__ f32x4 mfma16(bf16x8 a, bf16x8 b, f32x4 c) { return __builtin_amdgcn_mfma_f32_16x16x32_bf16(a, b, c, 0, 0, 0); }
__device__ __forceinline__ v4i16 trd(LAS const unsigned char* p) { return __builtin_amdgcn_ds_read_tr16_b64_v4i16((LAS v4i16*)p); }
__device__ __forceinline__ void tile_init(Tile& t) {
#pragma unroll
    for (int dt = 0; dt < 4; ++dt) t.o[dt] = (f32x4){0.f, 0.f, 0.f, 0.f};
    t.la = 0.f; t.m = M_INIT;
}
__device__ __forceinline__ bf16x8 tile_softmax(Tile& t, float (&x)[8]) {
    float mx = fmaxf(fmaxf(fmaxf(x[0], x[1]), fmaxf(x[2], x[3])), fmaxf(fmaxf(x[4], x[5]), fmaxf(x[6], x[7])));
    { const auto r16 = __builtin_amdgcn_permlane16_swap(__float_as_uint(mx), __float_as_uint(mx), false, false); mx = fmaxf(__uint_as_float(r16[0]), __uint_as_float(r16[1])); }
    { const auto r32 = __builtin_amdgcn_permlane32_swap(__float_as_uint(mx), __float_as_uint(mx), false, false); mx = fmaxf(__uint_as_float(r32[0]), __uint_as_float(r32[1])); }
    if (__any(mx > RESCALE_THR)) {
        const float d = fmaxf(mx, 0.f), alpha = __builtin_amdgcn_exp2f(-d); t.m += d;
#pragma unroll
        for (int i = 0; i < 8; ++i) x[i] -= d;
#pragma unroll
        for (int dt = 0; dt < 4; ++dt) t.o[dt] = t.o[dt] * alpha;
        t.la = t.la * alpha;
    }
    float p[8];
#pragma unroll
    for (int i = 0; i < 8; ++i) p[i] = __builtin_amdgcn_exp2f(x[i]);
    t.la += ((p[0] + p[1]) + (p[2] + p[3])) + ((p[4] + p[5]) + (p[6] + p[7]));
    u32x4 pw; pw.x = cvtpk(p[0], p[1]); pw.y = cvtpk(p[2], p[3]); pw.z = cvtpk(p[4], p[5]); pw.w = cvtpk(p[6], p[7]);
    return __builtin_bit_cast(bf16x8, pw);
}
__device__ __forceinline__ void tile_pv(Tile& t, const bf16x8 pf, const bf16x8 (&vf)[4]) {
#pragma unroll
    for (int dt = 0; dt < 4; ++dt) t.o[dt] = mfma16(vf[dt], pf, t.o[dt]);
}
__device__ __forceinline__ void read_vfrags(bf16x8 (&vf)[4], LAS const unsigned char* vp) {
#pragma unroll
    for (int dt = 0; dt < 4; ++dt) { const v4i16 lo = trd(vp + dt * 32), hi = trd(vp + 16 * VRS + dt * 32);
        vf[dt] = (bf16x8){lo[0], lo[1], lo[2], lo[3], hi[0], hi[1], hi[2], hi[3]}; }
}
template <int SH, int NT, int QS, int CS, int NP> __device__ __forceinline__ void dil_run(Tile (&tl)[NT], const bf16x8 (&qf)[NT][2], const bf16_t* qkv_seq, int h, int T, int qb, float sld, LAS unsigned char* vbuf, int lane) {
    constexpr int D = 1 << SH;
    const int n = lane & 15, g = lane >> 4;
    const int lo_t = 64 - (qb >> SH), hi_t = 64 + ((T - 1 - qb) >> SH);
    float relb[NT], rlo[NT], rhi[NT];
#pragma unroll
    for (int c = 0; c < NT; ++c) { const int off = 64 + CS * c + QS * n; relb[c] = (float)(4 * g - off); rlo[c] = (float)max(-64, lo_t - off); rhi[c] = (float)min(64, hi_t - off); }
    const char* kvbase = (const char*)(qkv_seq + 2048 + h * 64 + (lane & 7) * 8);
    const int vrow = lane >> 3;
    LAS unsigned char* vw = vbuf + vrow * VRS + (lane & 7) * 16;
    LAS unsigned char* kw = vbuf + VBUF + vrow * KRS + (lane & 7) * 16;
    LAS const unsigned char* vp = vbuf + (4 * g + (n >> 2)) * VRS + (n & 3) * 8;
    LAS const unsigned char* kr = vbuf + VBUF + n * KRS + g * 16;
    u32x4 kA[4], vA[4];
#define DIL_LOAD(p, KN, VN) do { \
    _Pragma("unroll") for (int i = 0; i < 4; ++i) { const int tok = min(max(qb + D * (32 * (p) + vrow + 8 * i - 64), 0), T - 1); \
        const char* rp = kvbase + (unsigned)tok * (unsigned)(QKVW * 2); KN[i] = *(const u32x4*)rp; VN[i] = *(const u32x4*)(rp + 1024); } } while (0)
#define DIL_STEP(p, KN, VN) do { \
        _Pragma("unroll") for (int i = 0; i < 4; ++i) *(LAS u32x4*)(kw + 8 * i * KRS) = KN[i]; \
        bf16x8 kf[2][2]; \
        _Pragma("unroll") for (int tt = 0; tt < 2; ++tt) { kf[tt][0] = *(LAS const bf16x8*)(kr + tt * 16 * KRS); kf[tt][1] = *(LAS const bf16x8*)(kr + tt * 16 * KRS + 64); } \
        _Pragma("unroll") for (int i = 0; i < 4; ++i) *(LAS u32x4*)(vw + 8 * i * VRS) = VN[i]; \
        if ((p) + 1 <= p_hi) DIL_LOAD((p) + 1, KN, VN); \
        bf16x8 pf[NT]; bool act[NT]; \
        _Pragma("unroll") for (int c = 0; c < NT; ++c) { \
              \
            act[c] = (CS < 16) || (32 * (p) + 31 >= CS * c && 32 * (p) <= CS * c + 15 * QS + 128); pf[c] = (bf16x8){0, 0, 0, 0, 0, 0, 0, 0}; \
            if (act[c]) { const float nm = -tl[c].m; const f32x4 negm = (f32x4){nm, nm, nm, nm}; f32x4 s[2]; \
            _Pragma("unroll") for (int tt = 0; tt < 2; ++tt) { s[tt] = mfma16(kf[tt][0], qf[c][0], negm); s[tt] = mfma16(kf[tt][1], qf[c][1], s[tt]); } \
            const float relp = relb[c] + (float)(32 * (p)); float x[8]; \
            _Pragma("unroll") for (int tt = 0; tt < 2; ++tt) \
            _Pragma("unroll") for (int r = 0; r < 4; ++r) { const float rel = relp + (float)(16 * tt + r); const float xv = fmaf(fabsf(rel), sld, s[tt][r]); \
                    x[4 * tt + r] = (__builtin_amdgcn_fmed3f(rel, rlo[c], rhi[c]) == rel) ? xv : -INFINITY; } \
            pf[c] = tile_softmax(tl[c], x); } } \
        bf16x8 vf[4]; read_vfrags(vf, vp); \
        _Pragma("unroll") for (int c = 0; c < NT; ++c) if (act[c]) tile_pv(tl[c], pf[c], vf); } while (0)
    const int p_lo = max(0, lo_t >> 5), p_hi = min(NP - 1, hi_t >> 5);
    DIL_LOAD(p_lo, kA, vA);
#pragma unroll 1
    for (int p = p_lo; p <= p_hi; ++p) DIL_STEP(p, kA, vA);
#undef DIL_STEP
#undef DIL_LOAD
}

__device__ __forceinline__ void na_quad(Tile (&tl)[4], const bf16x8 (&qf)[4][2], const bf16_t* qkv_seq, int h, int r, int rows, int nb, LAS const unsigned char* rpbh, LAS unsigned char* vbuf, int lane) {
    const int n = lane & 15, g = lane >> 4;
    const int qcol = 16 * nb + n, kstart = min(max(16 * nb - 8, 0), 32), wstart = min(max(qcol - 8, 0), 48), wofs = wstart - kstart, cb = kstart - qcol + 15 + 4 * g;
    const int rs0 = min(max(r - 4, 0), rows - 8);
    int boff[8];
#pragma unroll
    for (int tt = 0; tt < 2; ++tt)
#pragma unroll
        for (int q = 0; q < 4; ++q) { const int kc = 16 * tt + 4 * g + q; boff[4 * tt + q] = ((unsigned)(kc - wofs) < 16u) ? 4 * (cb + 16 * tt + q) : 4 * 31; }
    const char* kvbase = (const char*)(qkv_seq + 512 + h * 64 + (lane & 7) * 8);
    const int vrow = lane >> 3;
    LAS unsigned char* vw = vbuf + vrow * VRS + (lane & 7) * 16;
    LAS unsigned char* kw = vbuf + VBUF + vrow * KRS + (lane & 7) * 16;
    LAS const unsigned char* vp = vbuf + (4 * g + (n >> 2)) * VRS + (n & 3) * 8;
    LAS const unsigned char* kfr = vbuf + VBUF + n * KRS + g * 16;
    u32x4 kA[4], vA[4];
#define NA_LOAD(kr, KN, VN) do { const int tb = min(rs0 + (kr), rows - 1) * 64 + kstart + vrow; \
    _Pragma("unroll") for (int i = 0; i < 4; ++i) { const char* rp = kvbase + (unsigned)(tb + 8 * i) * (unsigned)(QKVW * 2); KN[i] = *(const u32x4*)rp; VN[i] = *(const u32x4*)(rp + 1024); } } while (0)
#define NA_STEP(kr, KN, VN) do { \
        _Pragma("unroll") for (int i = 0; i < 4; ++i) *(LAS u32x4*)(kw + 8 * i * KRS) = KN[i]; \
        bf16x8 kf[2][2]; \
        _Pragma("unroll") for (int tt = 0; tt < 2; ++tt) { kf[tt][0] = *(LAS const bf16x8*)(kfr + tt * 16 * KRS); kf[tt][1] = *(LAS const bf16x8*)(kfr + tt * 16 * KRS + 64); } \
        _Pragma("unroll") for (int i = 0; i < 4; ++i) *(LAS u32x4*)(vw + 8 * i * VRS) = VN[i]; \
        if ((kr) + 1 < 11) NA_LOAD((kr) + 1, KN, VN); \
        bf16x8 pf[4]; bool act[4]; \
        _Pragma("unroll") for (int c = 0; c < 4; ++c) { const int rsc = min(max(r + c - 4, 0), rows - 8), kk = rs0 + (kr) - rsc; act[c] = (unsigned)kk < 8u; pf[c] = (bf16x8){0, 0, 0, 0, 0, 0, 0, 0}; \
            if (act[c]) {                             \
            const float nm = -tl[c].m; const f32x4 negm = (f32x4){nm, nm, nm, nm}; f32x4 s[2]; \
            _Pragma("unroll") for (int tt = 0; tt < 2; ++tt) { s[tt] = mfma16(kf[tt][0], qf[c][0], negm); s[tt] = mfma16(kf[tt][1], qf[c][1], s[tt]); } \
            LAS const unsigned char* bt = rpbh + (rs0 + (kr) - (r + c) + 7) * 128; float x[8]; \
            _Pragma("unroll") for (int i = 0; i < 8; ++i) x[i] = s[i >> 2][i & 3] + *(LAS const float*)(bt + boff[i]); \
            pf[c] = tile_softmax(tl[c], x); } } \
        bf16x8 vf[4]; read_vfrags(vf, vp); \
        _Pragma("unroll") for (int c = 0; c < 4; ++c) if (act[c]) tile_pv(tl[c], pf[c], vf); } while (0)
    NA_LOAD(0, kA, vA);
#pragma unroll 1
    for (int kr = 0; kr < 11; ++kr) NA_STEP(kr, kA, vA);
#undef NA_STEP
#undef NA_LOAD
}

__device__ __forceinline__ void regroup(Tile (&tl)[4], LAS unsigned char* buf, int lane) {
    const int n = lane & 15, g = lane >> 4;
    const int qs0 = (n >> 2) * 16 + 4 * (n & 3);
#pragma unroll
    for (int hf = 0; hf < 2; ++hf) {
#pragma unroll
        for (int c = 0; c < 4; ++c)
#pragma unroll
            for (int d2 = 0; d2 < 2; ++d2) *(LAS f32x4*)(buf + (qs0 + c) * 128 + (d2 * 16 + 4 * g) * 4) = tl[c].o[2 * hf + d2];
        if (hf == 0) {
#pragma unroll
            for (int c = 0; c < 4; ++c) { *(LAS float*)(buf + 8192 + ((qs0 + c) * 4 + g) * 4) = tl[c].la; *(LAS float*)(buf + 9216 + (qs0 + c) * 4) = tl[c].m; }
        }
#pragma unroll
        for (int c = 0; c < 4; ++c)
#pragma unroll
            for (int d2 = 0; d2 < 2; ++d2) tl[c].o[2 * hf + d2] = *(LAS const f32x4*)(buf + (c * 16 + n) * 128 + (d2 * 16 + 4 * g) * 4);
        if (hf == 0) {
#pragma unroll
            for (int c = 0; c < 4; ++c) { tl[c].la = *(LAS const float*)(buf + 8192 + ((c * 16 + n) * 4 + g) * 4); tl[c].m = *(LAS const float*)(buf + 9216 + (c * 16 + n) * 4); }
        }
    }
}

__device__ __forceinline__ void finish_tile(Tile& t, LAS float* exch, int h, LAS const float* gainp  , bf16_t* orow, int lane) {
    const int n = lane & 15, g = lane >> 4;
    float l = t.la; l += __shfl_xor(l, 16); l += __shfl_xor(l, 32);
    const float inv = 1.0f / l; float ss = 0.f;
#pragma unroll
    for (int dt = 0; dt < 4; ++dt) { t.o[dt] = t.o[dt] * inv; const f32x4 v = t.o[dt]; ss += (v[0] * v[0] + v[1] * v[1]) + (v[2] * v[2] + v[3] * v[3]); }
    ss += __shfl_xor(ss, 16); ss += __shfl_xor(ss, 32);
    if (g == 0) exch[h * 16 + n] = ss;
    __syncthreads();
    float tot = 0.f;
#pragma unroll
    for (int hh = 0; hh < 8; ++hh) tot += exch[hh * 16 + n];
    const float rinv = 1.0f / sqrtf(tot * (1.0f / 512.0f) + RMS_EPS);
#pragma unroll
    for (int dt = 0; dt < 4; ++dt) { const f32x4 v = t.o[dt] * *(LAS const f32x4*)(gainp + 16 * dt) * rinv; u32x2 w; w.x = cvtpk(v[0], v[1]); w.y = cvtpk(v[2], v[3]); *(u32x2*)(orow + 16 * dt) = w; }
}
__device__ __forceinline__ void load_q(bf16x8 (&qf)[2], const bf16_t* qp) { qf[0] = *(const bf16x8*)qp; qf[1] = *(const bf16x8*)(qp + 32); }
#define ATT_PATTERN_FENCE() asm volatile("s_waitcnt vmcnt(0)\n\tbuffer_inv sc1\n\ts_waitcnt vmcnt(0)" ::: "memory")

#ifndef REP_DIL
#define REP_DIL 1
#endif
#ifndef REP_NA
#define REP_NA 1
#endif
__device__ __forceinline__ void attn_phase(LAS unsigned char* lds, const bf16_t* qkv, bf16_t* mix, const float* rpb, const float* g_na, const float* g_dil, int vcu, int G, const int wave) {
    int lane_ = __builtin_amdgcn_mbcnt_hi(~0u, __builtin_amdgcn_mbcnt_lo(~0u, 0u)); asm volatile("" : "+v"(lane_)); const int lane = lane_ & 63, h = wave, tid = h * 64 + lane, n = lane & 15, g = lane >> 4;
    LAS float* tab = (LAS float*)(lds + LDS_TAB);
    { LAS float* gl = (LAS float*)(lds + LDS_GAIN); for (int i = tid; i < 1024; i += 512) gl[i] = (i < 512) ? g_dil[i] : g_na[i - 512]; }
    for (int i = tid; i < 8 * 16 * 32; i += 512) { const int c = i & 31, rr = (i >> 5) & 15, hh = i >> 9; tab[i] = (c < 31 && rr < 15) ? rpb[(hh * 15 + rr) * 31 + c] * LOG2E : -INFINITY; }
    __syncthreads();
    LAS unsigned char* vbuf = lds + h * WBUF;
    LAS float* exch = (LAS float*)(lds + LDS_EXCH);
    int par = 0;
    {
        const float sl2 = -LOG2E * __builtin_amdgcn_exp2f(-(float)(h + 1));
        for (int rep = 0; rep < REP_DIL; ++rep)
        for (int item = vcu; item < 1280; item += G) {
            const int jr = item / G, u0r = (item - jr * G) >> 2; const int unit = (G == 256) ? jr * 64 + (u0r & ~7) + ((u0r + jr) & 7) : (item >> 2); const int pg = item & 3;
            int sb, T, u0;
            if (unit < 64) { sb = (unit >> 4) * 4096; T = 4096; u0 = (unit & 15) * 256; } else { const int uu = unit - 64; sb = NPROMPT + (uu >> 3) * 2048; T = 2048; u0 = (uu & 7) * 256; }
            const bf16_t* qkv_seq = qkv + (size_t)sb * QKVW;
            const bf16_t* qcolp = qkv_seq + 1536 + h * 64 + 8 * g;
            {
                const int ub = u0 + pg; Tile tl[4]; bf16x8 qf[4][2];
#pragma unroll
                for (int c = 0; c < 4; ++c) { tile_init(tl[c]); load_q(qf[c], qcolp + (size_t)(ub + 4 * c + 16 * n) * QKVW); }
#pragma unroll
                for (int c = 0; c < 4; ++c) { Tile t1[1]; bf16x8 q1[1][2]; t1[0] = tl[c]; q1[0][0] = qf[c][0]; q1[0][1] = qf[c][1];
                    dil_run<4, 1, 1, 0, 5>(t1, q1, qkv_seq, h, T, ub + 4 * c, sl2 * 16.0f, vbuf, lane);
                    tl[c] = t1[0]; }
#pragma unroll
                for (int c = 0; c < 4; ++c) load_q(qf[c], qcolp + (size_t)(ub + 64 * c + 4 * n) * QKVW);
                regroup(tl, vbuf, lane);
                dil_run<2, 4, 1, 16, 6>(tl, qf, qkv_seq, h, T, ub, sl2 * 4.0f, vbuf, lane);
                dil_run<0, 4, 4, 64, 12>(tl, qf, qkv_seq, h, T, ub, sl2, vbuf, lane);
#pragma unroll
                for (int c = 0; c < 4; ++c) {
                    int lane2 = lane; asm volatile("" : "+v"(lane2));
                    const int n2 = lane2 & 15, g2 = lane2 >> 4;
                    finish_tile(tl[c], exch + par * 128, h, (LAS const float*)(lds + LDS_GAIN) + h * 64 + 4 * g2, mix + (size_t)(sb + ub + 64 * c + 4 * n2) * DM + 512 + h * 64 + 4 * g2, lane2);
                    par ^= 1; }
            }
        }
    }
    {
        int lane_n = __builtin_amdgcn_mbcnt_hi(~0u, __builtin_amdgcn_mbcnt_lo(~0u, 0u)); asm volatile("" : "+v"(lane_n)); const int lane = lane_n & 63, n = lane & 15, g = lane >> 4;
        LAS const unsigned char* rpbh = (LAS const unsigned char*)(tab + h * (16 * 32));
        for (int rep = 0; rep < REP_NA; ++rep)
        for (int item = vcu; item < 1280; item += G) {
            const int qd = item >> 2, nb = item & 3;
            int sb, rows, r;
            if (qd < 64) { sb = (qd >> 4) * 4096; rows = 64; r = (qd & 15) * 4; } else { const int ii = qd - 64; sb = NPROMPT + (ii >> 3) * 2048; rows = 32; r = (ii & 7) * 4; }
            const bf16_t* qkv_seq = qkv + (size_t)sb * QKVW;
            Tile tl[4]; bf16x8 qf[4][2];
#pragma unroll
            for (int c = 0; c < 4; ++c) { tile_init(tl[c]); load_q(qf[c], qkv_seq + (size_t)((r + c) * 64 + 16 * nb + n) * QKVW + h * 64 + 8 * g); }
            na_quad(tl, qf, qkv_seq, h, r, rows, nb, rpbh, vbuf, lane);
#pragma unroll
            for (int c = 0; c < 4; ++c) { int lane2 = lane; asm volatile("" : "+v"(lane2)); const int n2 = lane2 & 15, g2 = lane2 >> 4;
                finish_tile(tl[c], exch + par * 128, h, (LAS const float*)(lds + LDS_GAIN) + 512 + h * 64 + 4 * g2, mix + (size_t)(sb + (r + c) * 64 + 16 * nb + n2) * DM + h * 64 + 4 * g2, lane2); par ^= 1; }
        }
    }
    __syncthreads();
}
}

__device__ __forceinline__ void transpose_item(const float* W, int K, int N, bf16_t* WT, int k0, int n0, int dst_row0, const float* kgain, float sn, LAS float* scr, int lane) {
#pragma unroll
    for (int i = 0; i < 32; ++i) { const int kk = 2 * i + (lane >> 5); float v = W[(size_t)(k0 + kk) * N + n0 + (lane & 31)] * sn; if (kgain) v *= kgain[k0 + kk]; scr[kk * 33 + (lane & 31)] = v; }
    asm volatile("s_waitcnt lgkmcnt(0)" ::: "memory");
    const int c = lane & 7;
#pragma unroll
    for (int j = 0; j < 4; ++j) { const int nn = (lane >> 3) + 8 * j; const LAS float* s = scr + (8 * c) * 33 + nn;
        u32x4 o; o.x = cvtpk(s[0 * 33], s[1 * 33]); o.y = cvtpk(s[2 * 33], s[3 * 33]); o.z = cvtpk(s[4 * 33], s[5 * 33]); o.w = cvtpk(s[6 * 33], s[7 * 33]);
        *(u32x4*)(WT + (size_t)(dst_row0 + nn) * K + k0 + 8 * c) = o; }
    asm volatile("s_waitcnt lgkmcnt(0)" ::: "memory");
}
template <bool TOBF> __device__ __forceinline__ void rms_row(const float* xrow, const float* gain, void* orow, int lane) {
    const f32x4* xr = (const f32x4*)xrow + lane; const f32x4* gr = (const f32x4*)gain + lane;
    f32x4 v[4]; float s = 0.f;
#pragma unroll
    for (int j = 0; j < 4; ++j) { v[j] = xr[64 * j]; s += (v[j][0] * v[j][0] + v[j][1] * v[j][1]) + (v[j][2] * v[j][2] + v[j][3] * v[j][3]); }
    const float rinv = 1.0f / sqrtf(wave_sum(s) * (1.0f / 1024.0f) + RMS_EPS);
#pragma unroll
    for (int j = 0; j < 4; ++j) { const f32x4 o = v[j] * rinv * gr[64 * j];
        if (TOBF) { u32x2 w; w.x = cvtpk(o[0], o[1]); w.y = cvtpk(o[2], o[3]); ((u32x2*)orow)[64 * j + lane] = w; }
        else ((f32x4*)orow)[64 * j + lane] = o; }
}

template <bool TOBF> __device__ __forceinline__ void rms_rows(const float* p0, const float* p1, const float* gain, void* obase, int gw, int NGW, int lane, float* srow) {
    f32x4 gr[4], a[4], b[4], c[4];
#pragma unroll
    for (int j = 0; j < 4; ++j) gr[j] = ((const f32x4*)gain)[64 * j + lane];
#define RR_LOAD(dst, mm) do { const int m_ = min((mm), MROWS - 1); const f32x4* xr_ = (const f32x4*)(m_ < NPROMPT ? p0 + (size_t)m_ * DM : p1 + (size_t)(m_ - NPROMPT) * DM) + lane; \
    _Pragma("unroll") for (int j = 0; j < 4; ++j) dst[j] = xr_[64 * j]; } while (0)
    RR_LOAD(a, gw); RR_LOAD(b, gw + NGW);
    for (int m = gw; m < MROWS; m += NGW) {
        RR_LOAD(c, m + 2 * NGW);
        float s = 0.f;
#pragma unroll
        for (int j = 0; j < 4; ++j) s += (a[j][0] * a[j][0] + a[j][1] * a[j][1]) + (a[j][2] * a[j][2] + a[j][3] * a[j][3]);
        const float rms = sqrtf(wave_sum(s) * (1.0f / 1024.0f) + RMS_EPS), rinv = 1.0f / rms;
        if (srow && lane == 0) srow[m] = rms;
#pragma unroll
        for (int j = 0; j < 4; ++j) { const f32x4 o = a[j] * rinv * gr[j];
            if (TOBF) { u32x2 w; w.x = cvtpk(o[0], o[1]); w.y = cvtpk(o[2], o[3]); ((u32x2*)obase)[(size_t)m * 256 + 64 * j + lane] = w; }
            else ((f32x4*)obase)[(size_t)m * 256 + 64 * j + lane] = o; }
#pragma unroll
        for (int j = 0; j < 4; ++j) { a[j] = b[j]; b[j] = c[j]; }
    }
#undef RR_LOAD
}

__device__ __forceinline__ void final_rows(const bf16_t* y, const float* ss, const float* gain, float* out, int gw, int NGW, int lane) {
    f32x4 gr[4]; u32x2 a[4], b[4], c[4]; float sa, sb, sc;
#pragma unroll
    for (int j = 0; j < 4; ++j) gr[j] = ((const f32x4*)gain)[64 * j + lane];
#define FR_LOAD(dst, sd, mm) do { const int m_ = min((mm), MROWS - 1); const u32x2* yr_ = (const u32x2*)(y + (size_t)m_ * DM) + lane; \
    _Pragma("unroll") for (int j = 0; j < 4; ++j) dst[j] = yr_[64 * j]; sd = ss[(size_t)m_ * 16 + (lane & 15)]; } while (0)
    FR_LOAD(a, sa, gw); FR_LOAD(b, sb, gw + NGW);
    for (int m = gw; m < MROWS; m += NGW) {
        FR_LOAD(c, sc, m + 2 * NGW);
        float t = sa; t += __shfl_xor(t, 1); t += __shfl_xor(t, 2); t += __shfl_xor(t, 4); t += __shfl_xor(t, 8);
        const float rinv = 1.0f / sqrtf(t * (1.0f / 1024.0f) + RMS_EPS);
#pragma unroll
        for (int j = 0; j < 4; ++j) { const f32x4 v = (f32x4){__uint_as_float(a[j].x << 16), __uint_as_float(a[j].x & 0xffff0000u), __uint_as_float(a[j].y << 16), __uint_as_float(a[j].y & 0xffff0000u)};
            ((f32x4*)out)[(size_t)m * 256 + 64 * j + lane] = v * rinv * gr[j]; }
#pragma unroll
        for (int j = 0; j < 4; ++j) { a[j] = b[j]; b[j] = c[j]; }
        sa = sb; sb = sc;
    }
#undef FR_LOAD
}

#define XB_TMO      128
#define XB_XCNT(j)  (256  + 64 * (j))
#define XB_XSUB(j)  (1280 + 64 * (j))
#define XB_XGEN(j)  (2304 + 64 * (j))
#define XB_TOP      3328
#define XB_TOPGEN   3392
#define XCD_BAR_WORDS 3456
#define XB_SPIN_CAP (1u << 18)

__device__ __forceinline__ unsigned xb_ld(unsigned* p)              { return __hip_atomic_load(p, __ATOMIC_RELAXED, __HIP_MEMORY_SCOPE_AGENT); }
__device__ __forceinline__ unsigned xb_add(unsigned* p, unsigned v) { return __hip_atomic_fetch_add(p, v, __ATOMIC_RELAXED, __HIP_MEMORY_SCOPE_AGENT); }
__device__ __forceinline__ unsigned xb_xcc_id() { return (unsigned)__builtin_amdgcn_s_getreg((3 << 11) | 20) & 0xFu; }
#define XB_SPIN(cond, bar) do { unsigned _sp = 0; while (cond) { __builtin_amdgcn_s_sleep(1); \
    if ((++_sp & 255u) == 0u) { if (xb_ld(&(bar)[XB_TMO])) break; if (_sp > XB_SPIN_CAP) { atomicAdd(&(bar)[XB_TMO], 1u); break; } } } } while (0)

struct XcdBarrier {
    unsigned* bar; unsigned x;
    volatile LAS unsigned* st;
};

__device__ __forceinline__ XcdBarrier xcd_barrier_post(unsigned* bar, volatile LAS unsigned* st) {
    XcdBarrier b; b.bar = bar; b.x = xb_xcc_id(); b.st = st;
    if (threadIdx.x == 0) (void)xb_add(&bar[XB_XCNT(b.x)], 1u);
    return b;
}
__device__ __forceinline__ void xcd_barrier_complete(unsigned* bar, unsigned x, unsigned& nloc, unsigned& nx) {
    const unsigned G = gridDim.x * gridDim.y * gridDim.z;
    unsigned sum, cnt, mine, sp = 0u;
    for (;;) {
        sum = 0u; cnt = 0u; mine = 0u;
#pragma unroll
        for (unsigned j = 0; j < 16; ++j) { const unsigned c = xb_ld(&bar[XB_XCNT(j)]); sum += c; cnt += (c > 0u) ? 1u : 0u; mine = (j == x) ? c : mine; }
        if (sum == G) break;
        __builtin_amdgcn_s_sleep(1);
        if ((++sp & 255u) == 0u) { if (xb_ld(&bar[XB_TMO])) break; if (sp > XB_SPIN_CAP) { atomicAdd(&bar[XB_TMO], 1u); break; } }
    }
    nloc = mine > 0u ? mine : 1u; nx = cnt > 0u ? cnt : 1u;
}

__device__ __forceinline__ void xcd_barrier(const XcdBarrier& b, const int wave) {
    asm volatile("s_waitcnt vmcnt(0)" ::: "memory");
    __syncthreads();
    if (wave == 0 && __builtin_amdgcn_mbcnt_hi(~0u, __builtin_amdgcn_mbcnt_lo(~0u, 0u)) == 0u) {
        unsigned* bar = b.bar;
        __builtin_amdgcn_s_waitcnt(0);
        unsigned nloc = b.st[0], nx = b.st[1];
        if (nloc == 0u) { xcd_barrier_complete(bar, b.x, nloc, nx); b.st[0] = nloc; b.st[1] = nx; }
        const unsigned old = xb_add(&bar[XB_XSUB(b.x)], 1u);
        const unsigned gen = old / nloc;
        if (old + 1u == (gen + 1u) * nloc) {
            __builtin_amdgcn_fence(__ATOMIC_RELEASE, "agent");
            asm volatile("s_waitcnt vmcnt(0)" ::: "memory");
            const unsigned og = xb_add(&bar[XB_TOP], 1u);
            const unsigned tg = og / nx;
            if (og + 1u == (tg + 1u) * nx) xb_add(&bar[XB_TOPGEN], 1u);
            else XB_SPIN(xb_ld(&bar[XB_TOPGEN]) == tg, bar);
            __builtin_amdgcn_fence(__ATOMIC_ACQUIRE, "agent");
            xb_add(&bar[XB_XGEN(b.x)], 1u);
            asm volatile("s_waitcnt vmcnt(0)" ::: "memory");
        } else {
            XB_SPIN(xb_ld(&bar[XB_XGEN(b.x)]) == gen, bar);
            __builtin_amdgcn_fence(__ATOMIC_ACQUIRE, "agent");
            asm volatile("s_waitcnt vmcnt(0)" ::: "memory");
        }
    }
    __syncthreads();
}

struct Args { const float* in[13]; float* out; unsigned char* ws; };

#define GRID_SYNC() do { asm volatile("s_waitcnt vmcnt(0)" ::: "memory"); grid.sync(); asm volatile("buffer_inv sc1\n\ts_waitcnt vmcnt(0)" ::: "memory"); } while (0)
#define XSYNC() xcd_barrier(xbar, wave)
__global__ void __launch_bounds__(512, 2) hymba_fwd(Args a) {
    extern __shared__ __attribute__((aligned(16))) unsigned char lds_raw[];
    cg::grid_group grid = cg::this_grid();
    LAS unsigned char* lds = (LAS unsigned char*)lds_raw;
    const int wave = __builtin_amdgcn_readfirstlane((int)threadIdx.x >> 6);
    volatile LAS unsigned* xst = (volatile LAS unsigned*)(lds + RING_BYTES + 64);
    if (threadIdx.x < 2) xst[threadIdx.x] = 0u;
    __syncthreads();
    const XcdBarrier xbar = xcd_barrier_post((unsigned*)(a.ws + 4096), xst);
    const int G = gridDim.x, bx = blockIdx.x, vcu = (G % 8 == 0) ? (bx % 8) * (G / 8) + bx / 8 : bx;
    unsigned char* ws = a.ws;
    bf16_t* Win_t = (bf16_t*)(ws + WS_WIN); bf16_t* Wo_t = (bf16_t*)(ws + WS_WO); bf16_t* Wgu_t = (bf16_t*)(ws + WS_WGU); bf16_t* Wd_t = (bf16_t*)(ws + WS_WD);
    float* SS = (float*)(ws + WS_SS); bf16_t* XN = (bf16_t*)(ws + WS_XN); bf16_t* MIX = (bf16_t*)(ws + WS_MIX); bf16_t* QKV = (bf16_t*)(ws + WS_QKV); bf16_t* HB = (bf16_t*)(ws + WS_QKV);
    const float* xp = a.in[0]; const float* xs = a.in[1];
    const int gw = vcu * 8 + wave, NGW = G * 8;

#ifndef REP_P0
#define REP_P0 1
#endif
    for (int rep0 = 0; rep0 < REP_P0; ++rep0) {
        int lane = __builtin_amdgcn_mbcnt_hi(~0u, __builtin_amdgcn_mbcnt_lo(~0u, 0u)); asm volatile("" : "+v"(lane)); lane &= 63;
        LAS float* scr = (LAS float*)(lds + wave * 16384);
        constexpr int I_IN = 16 * 96, I_O = 16 * 32, I_G = 16 * 88, I_D = 44 * 32, NITEMS = I_IN + I_O + 2 * I_G + I_D;
        for (int it = gw; it < NITEMS; it += NGW) {
            int r = it;
            if (r < I_IN) { const int kb = r / 96, nb = r % 96, n0 = 32 * nb; const float sn = (n0 < 512 || (n0 >= 1536 && n0 < 2048)) ? 0.125f * LOG2E : 1.0f;
                transpose_item(a.in[2], 1024, QKVW, Win_t, 64 * kb, n0, n0, nullptr, sn, scr, lane); continue; } r -= I_IN;
            if (r < I_O) { const int kb = r / 32, nb = r % 32; transpose_item(a.in[7], 1024, 1024, Wo_t, 64 * kb, 32 * nb, 32 * nb, nullptr, 1.0f, scr, lane); continue; } r -= I_O;
            if (r < 2 * I_G) { const int up = r >= I_G ? 1 : 0; if (up) r -= I_G; const int kb = r / 88, nb = r % 88, n0 = 32 * nb;
                transpose_item(up ? a.in[10] : a.in[9], 1024, DFF, Wgu_t, 64 * kb, n0, (n0 >> 7) * 256 + (n0 & 127) + up * 128, a.in[8], 1.0f, scr, lane); continue; } r -= 2 * I_G;
            { const int kb = r / 32, nb = r % 32; transpose_item(a.in[11], DFF, 1024, Wd_t, 64 * kb, 32 * nb, 32 * nb, nullptr, 1.0f, scr, lane); }
        }
        if (gw == 0) { float* gi = (float*)(ws + WS_GINV); for (int i = lane; i < 1024; i += 64) gi[i] = 1.0f / a.in[4][i]; }
        rms_rows<true>(xp, xs, a.in[4], XN, gw, NGW, lane, (float*)(ws + WS_SROW));
    }
    GRID_SYNC();
#ifdef REP_SYNC
    for (int rs_ = 0; rs_ < REP_SYNC; ++rs_) GRID_SYNC();
#endif
    {
        pg8::Gemm g{XN, Win_t, MROWS, QKVW, 1024}; pg8::StaticOrder S; S.init(MROWS, QKVW, G, bx);
        pg8::EpiStoreBf16 E{QKV, QKVW};
        pg8::gemm_phase<pg8::EpiStoreBf16, pg8::StaticOrder, true, true>(lds, g, S, E, wave);
#ifdef REP_P1
        pg8::gemm_phase<pg8::EpiStoreBf16, pg8::StaticOrder, true, true>(lds, g, S, E, wave);
#endif
    }
    XSYNC();
    att::attn_phase(lds, QKV, MIX, a.in[3], a.in[5], a.in[6], vcu, G, wave);
    XSYNC();
    {
        pg8::Gemm g{MIX, Wo_t, MROWS, 1024, 1024}; pg8::StaticOrder S; S.init(MROWS, 1024, G, bx);
        pg8::EpiResid<true> E{(const float*)(ws + WS_SROW), (const float*)(ws + WS_GINV), NPROMPT, XN, XN, SS};
        pg8::gemm_phase<pg8::EpiResid<true>, pg8::StaticOrder, true, true>(lds, g, S, E, wave);
#ifdef REP_P3
        pg8::gemm_phase<pg8::EpiResid<true>, pg8::StaticOrder, true, true>(lds, g, S, E, wave);
#endif
    }
    XSYNC();
    {
        pg8::Gemm g{XN, Wgu_t, MROWS, GUW, 1024}; pg8::StaticOrder S; S.init(MROWS, GUW, G, bx);
        pg8::EpiSwiglu E{HB, DFF, SS};
        pg8::gemm_phase<pg8::EpiSwiglu, pg8::StaticOrder, true, true>(lds, g, S, E, wave);
#ifdef REP_P4
        pg8::gemm_phase<pg8::EpiSwiglu, pg8::StaticOrder, true, true>(lds, g, S, E, wave);
#endif
    }
    XSYNC();
    {
        pg8::Gemm g{HB, Wd_t, MROWS, 1024, DFF}; pg8::StaticOrder S; S.init(MROWS, 1024, G, bx);
        pg8::EpiResid<false> E{nullptr, nullptr, 0, XN, MIX, SS};
        pg8::gemm_phase<pg8::EpiResid<false>, pg8::StaticOrder, true, true>(lds, g, S, E, wave);
    }
    XSYNC();
    { int l6 = __builtin_amdgcn_mbcnt_hi(~0u, __builtin_amdgcn_mbcnt_lo(~0u, 0u)); asm volatile("" : "+v"(l6)); l6 &= 63;
      final_rows(MIX, SS, a.in[12], a.out, gw, NGW, l6); }
}

extern "C" void kernel_launch(void* const* d_in, const int* in_sizes, int n_in, void* d_out, int out_size, void* d_ws, size_t ws_size, hipStream_t stream) {
    static int grid = 0;
    if (grid == 0) {
        if (n_in != 13 || out_size != MROWS * DM || ws_size < WS_END) { fprintf(stderr, "kernel_launch: unexpected shapes (n_in %d out %d ws %zu)\n", n_in, out_size, ws_size); grid = -1; return; }
        int dev = 0, cus = 0, per_cu = 0;
        hipGetDevice(&dev); hipDeviceGetAttribute(&cus, hipDeviceAttributeMultiprocessorCount, dev);
        if (hipFuncSetAttribute((const void*)hymba_fwd, hipFuncAttributeMaxDynamicSharedMemorySize, LDS_BYTES) != hipSuccess) { fprintf(stderr, "kernel_launch: hipFuncSetAttribute failed\n"); }
        if (hipOccupancyMaxActiveBlocksPerMultiprocessor(&per_cu, (const void*)hymba_fwd, 512, LDS_BYTES) != hipSuccess || per_cu < 1) { fprintf(stderr, "kernel_launch: occupancy query says %d\n", per_cu); per_cu = 1; }
        (void)hipGetLastError();
        grid = cus * per_cu;
    }
    if (grid < 0) return;
    if (hipMemsetAsync(d_ws, 0, 32768, stream) != hipSuccess) { fprintf(stderr, "kernel_launch: memset of the barrier words failed\n"); return; }
    Args a{};
    for (int i = 0; i < 13; ++i) a.in[i] = (const float*)d_in[i];
    a.out = (float*)d_out; a.ws = (unsigned char*)d_ws;
    void* args[] = {&a};
    hipError_t e = hipLaunchCooperativeKernel((const void*)hymba_fwd, dim3(grid), dim3(512), args, LDS_BYTES, stream);
    if (e != hipSuccess) fprintf(stderr, "cooperative launch failed: %s (grid %d)\n", hipGetErrorString(e), grid);
}
```

```cpp
#include <hip/hip_runtime.h>
#include <hip/hip_cooperative_groups.h>
#include <cstdio>
#include <cstdint>
namespace cg = cooperative_groups;
namespace pg8 {
#define PG8_LAS __attribute__((address_space(3)))
typedef unsigned short bf16_t;
typedef short bf16x8 __attribute__((ext_vector_type(8)));
typedef float f32x4 __attribute__((ext_vector_type(4)));
typedef unsigned u32x4 __attribute__((ext_vector_type(4)));
constexpr int BM = 256, BK = 64, HALF = 128, HTB = HALF * BK * 2  , STAGE_BYTES = 8 * HTB, NXCD = 8, WGM = 8;

__host__ __device__ __forceinline__ int lds_byte(int r, int c) { const int st = (r >> 4) * 2 + (c >> 5), rr = r & 15, cc = c & 31, ob = rr * 64 + cc * 2; return st * 1024 + (ob ^ (((ob >> 9) & 1) << 5)); }
__host__ __device__ __forceinline__ void stage_rc(int b, int& R, int& C) { const int st = b / 1024, sb = b % 1024, swz = sb ^ (((sb >> 9) & 1) << 5); R = (st >> 1) * 16 + swz / 64; C = (st & 1) * 32 + (swz % 64) / 2; }
__host__ __device__ __forceinline__ int perm32(int rho) { const int n = rho >> 4, i = rho & 15; return 8 * (i >> 2) + 4 * n + (i & 3); }

struct Unit { int pm, pn; };
struct Gemm { const bf16_t* A; const bf16_t* Bt; int M, N, K; };

struct StaticOrder {
    int nM, nN, nwg, G, c;
    __host__ __device__ void init(int M, int N, int G_, int c_) { nM = M / BM; nN = N / BM; nwg = nM * nN; G = G_; c = c_; }
    __host__ __device__ bool next(int i, Unit& u) const {
        const long L = (long)i * G + c; if (L >= nwg) return false;
        int wgid = (int)L; { const int q = nwg / NXCD, r = nwg % NXCD, xcd = wgid % NXCD, off = wgid / NXCD; wgid = (xcd < r ? xcd * (q + 1) : r * (q + 1) + (xcd - r) * q) + off; }
        const int nig = WGM * nN, gid = wgid / nig, fm = gid * WGM, gsz = (nM - fm) < WGM ? (nM - fm) : WGM;
        u.pm = fm + ((wgid % nig) % gsz); u.pn = (wgid % nig) / gsz; return true;
    }
    __device__ __forceinline__ void a_ready(const Unit&) const {}
    __device__ __forceinline__ void done(const Unit&) const {}
};


typedef float f32x2_t __attribute__((ext_vector_type(2))); typedef __bf16 bf16x2_t __attribute__((ext_vector_type(2)));
__device__ __forceinline__ unsigned cvt_pk_bf16(float lo, float hi) { const f32x2_t v = {lo, hi}; const bf16x2_t b = __builtin_convertvector(v, bf16x2_t); return __builtin_bit_cast(unsigned, b); }
typedef unsigned u32x2 __attribute__((ext_vector_type(2)));

struct EpiStoreBf16 {
    static constexpr bool PERM = true, AFTER_DRAIN = false;
    bf16_t* O; int ldc;
    __device__ __forceinline__ void operator()(const f32x4 (&acc)[2][2][4][2], const Unit& u, int wr, int wc, int fr, int fq) const {
        const int row0 = u.pm * BM + wr * 64 + fr, col0 = u.pn * BM + wc * 32 + 8 * fq;
#pragma unroll
        for (int ai = 0; ai < 2; ++ai)
#pragma unroll
            for (int m = 0; m < 4; ++m) { bf16_t* rowp = O + (size_t)(row0 + ai * HALF + m * 16) * ldc + col0;
#pragma unroll
                for (int bj = 0; bj < 2; ++bj) { const f32x4 v0 = acc[ai][bj][m][0], v1 = acc[ai][bj][m][1];
                    u32x4 w; w.x = cvt_pk_bf16(v0[0], v0[1]); w.y = cvt_pk_bf16(v0[2], v0[3]); w.z = cvt_pk_bf16(v1[0], v1[1]); w.w = cvt_pk_bf16(v1[2], v1[3]);
                    *(u32x4*)(rowp + bj * HALF) = w; } }
    }
};

template <bool FIRST> struct EpiResid {
    static constexpr bool PERM = false, AFTER_DRAIN = false;
    const float* xp; const float* xs; int split; const bf16_t* rb; bf16_t* ob; float* ss;
    __device__ __forceinline__ void operator()(const f32x4 (&acc)[2][2][4][2], const Unit& u, int wr, int wc, int fr, int fq) const {
        const int row0 = u.pm * BM + wr * 64 + fr, col0 = u.pn * BM + wc * 32 + 4 * fq;
#pragma unroll
        for (int ai = 0; ai < 2; ++ai)
#pragma unroll
            for (int m = 0; m < 4; ++m) { const int row = row0 + ai * HALF + m * 16;
                const float* rp = FIRST ? ((row < split ? xp + (size_t)row * 1024 : xs + (size_t)(row - split) * 1024) + col0) : nullptr;
                const bf16_t* rbp = FIRST ? nullptr : rb + (size_t)row * 1024 + col0;
                bf16_t* op = ob + (size_t)row * 1024 + col0;
                float s = 0.f;
#pragma unroll
                for (int bj = 0; bj < 2; ++bj)
#pragma unroll
                    for (int n = 0; n < 2; ++n) { const int c = bj * HALF + n * 16; f32x4 r;
                        if (FIRST) r = *(const f32x4*)(rp + c);
                        else { const u32x2 w = *(const u32x2*)(rbp + c); r = (f32x4){__uint_as_float(w.x << 16), __uint_as_float(w.x & 0xffff0000u), __uint_as_float(w.y << 16), __uint_as_float(w.y & 0xffff0000u)}; }
                        const f32x4 v = r + acc[ai][bj][m][n];
                        u32x2 w; w.x = cvt_pk_bf16(v[0], v[1]); w.y = cvt_pk_bf16(v[2], v[3]); *(u32x2*)(op + c) = w;
                        s += (v[0] * v[0] + v[1] * v[1]) + (v[2] * v[2] + v[3] * v[3]); }
                s += __shfl_xor(s, 16); s += __shfl_xor(s, 32); if (fq == 0) ss[(size_t)row * 16 + u.pn * 4 + wc] = s; }
    }
};

struct EpiSwiglu {
    static constexpr bool PERM = true, AFTER_DRAIN = false;
    bf16_t* H; int ldh; const float* ss; PG8_LAS float* rtab;
    mutable int pm_c;
    __device__ __forceinline__ void operator()(const f32x4 (&acc)[2][2][4][2], const Unit& u, int wr, int wc, int fr, int fq) const {
        const int row0 = u.pm * BM + wr * 64 + fr, f0 = u.pn * HALF + wc * 32 + 8 * fq;
        PG8_LAS float* rt = rtab + (wr * 4 + wc) * 128;
        if (u.pm != pm_c) {
            pm_c = u.pm;
            const int L = fq * 16 + fr;
#pragma unroll
            for (int k = 0; k < 2; ++k) { const int t = L + 64 * k, row = u.pm * BM + wr * 64 + (t >> 6) * HALF + (t & 63);
                const f32x4* sp = (const f32x4*)(ss + (size_t)row * 16); const f32x4 a = sp[0], b = sp[1], c = sp[2], d = sp[3];
                const float tot = ((a[0] + a[1]) + (a[2] + a[3])) + ((b[0] + b[1]) + (b[2] + b[3])) + ((c[0] + c[1]) + (c[2] + c[3])) + ((d[0] + d[1]) + (d[2] + d[3]));
                rt[t] = 1.0f / sqrtf(tot * (1.0f / 1024.0f) + 1e-6f); }
        }
#pragma unroll
        for (int ai = 0; ai < 2; ++ai)
#pragma unroll
            for (int m = 0; m < 4; ++m) { const int row = row0 + ai * HALF + m * 16;
                const float rinv = rt[ai * 64 + m * 16 + fr];
                float hv[8];
#pragma unroll
                for (int n = 0; n < 2; ++n)
#pragma unroll
                    for (int i = 0; i < 4; ++i) { const float g = acc[ai][0][m][n][i] * rinv, up = acc[ai][1][m][n][i] * rinv;
                        const float e = __builtin_amdgcn_exp2f(g * -1.4426950408889634f); hv[n * 4 + i] = g * __builtin_amdgcn_rcpf(1.0f + e) * up; }
                u32x4 w; w.x = cvt_pk_bf16(hv[0], hv[1]); w.y = cvt_pk_bf16(hv[2], hv[3]); w.z = cvt_pk_bf16(hv[4], hv[5]); w.w = cvt_pk_bf16(hv[6], hv[7]);
                *(u32x4*)(H + (size_t)row * ldh + f0) = w; }
    }
};

template <class Epi, class Sched, bool ALIGN_EPI = false, bool SP2 = false>
__device__ __forceinline__ void gemm_phase(PG8_LAS unsigned char* lds, const Gemm g, const Sched& S, const Epi& E, const int wid_in) {
    int lane_ = __builtin_amdgcn_mbcnt_hi(~0u, __builtin_amdgcn_mbcnt_lo(~0u, 0u)); asm volatile("" : "+v"(lane_)); const int wid = wid_in, lane = lane_ & 63, tid = wid * 64 + lane, wr = wid >> 2, wc = wid & 3, fr = lane & 15, fq = lane >> 4;
    const int K = g.K, nt = K / BK;
    unsigned voffA[2], voffB[2];
#pragma unroll
    for (int i = 0; i < 2; ++i) { int R, C; stage_rc(tid * 16 + i * 8192, R, C); const int Rb = Epi::PERM ? ((R & ~31) + perm32(R & 31)) : R;
        voffA[i] = (unsigned)(R * K + C) * 2u; voffB[i] = (unsigned)(Rb * K + C) * 2u; }
    const size_t kstep = (size_t)(BK * 2);
    const size_t hstep = (size_t)HALF * K * 2;
    const size_t tstep = 2 * hstep;
    const unsigned ldsw = (unsigned)wid * 1024u;
    const int aoff = lds_byte(wr * 64 + fr, fq * 8), boff = lds_byte(wc * 32 + fr, fq * 8);
#define PG8_SA(b, h) (((b) * 2 + (h)) * HTB)
#define PG8_SB(b, h) ((4 + (b) * 2 + (h)) * HTB)
#define PG8_STAGE(bufoff, gbase, voff) do { _Pragma("unroll") for (int _i = 0; _i < 2; ++_i) \
        __builtin_amdgcn_global_load_lds((const unsigned*)((const char*)(gbase) + (voff)[_i]), (PG8_LAS unsigned*)(lds + (bufoff) + ldsw + _i * 8192), 16, 0, 0); } while (0)
#define PG8_LDA(dst, b, h) do { _Pragma("unroll") for (int m = 0; m < 4; ++m) _Pragma("unroll") for (int k = 0; k < 2; ++k) dst[m][k] = *(const PG8_LAS bf16x8*)(lds + PG8_SA(b, h) + aoff + m * 2048 + k * 1024); } while (0)
#define PG8_LDB(dst, b, h) do { _Pragma("unroll") for (int n = 0; n < 2; ++n) _Pragma("unroll") for (int k = 0; k < 2; ++k) dst[n][k] = *(const PG8_LAS bf16x8*)(lds + PG8_SB(b, h) + boff + n * 2048 + k * 1024); } while (0)
#define PG8_MMA(ai, bj, At, Bt) do { __builtin_amdgcn_s_setprio(1); _Pragma("unroll") for (int m = 0; m < 4; ++m) _Pragma("unroll") for (int n = 0; n < 2; ++n) _Pragma("unroll") for (int k = 0; k < 2; ++k) \
        acc[ai][bj][m][n] = __builtin_amdgcn_mfma_f32_16x16x32_bf16(Bt[n][k], At[m][k], acc[ai][bj][m][n], 0, 0, 0); __builtin_amdgcn_s_setprio(0); } while (0)
#define PG8_WAIT_V(n) asm volatile("s_waitcnt vmcnt(" #n ")" ::: "memory")
#define PG8_WAIT_L(n) asm volatile("s_waitcnt lgkmcnt(" #n ")" ::: "memory")
#define PG8_BAR __builtin_amdgcn_s_barrier()
#define PG8_SCHED __builtin_amdgcn_sched_barrier(0)
    Unit cur, nxt; int ui = 0;
    if (!S.next(0, cur)) return;
    f32x4 acc[2][2][4][2];
#pragma unroll
    for (int a = 0; a < 2; ++a)
#pragma unroll
        for (int b = 0; b < 2; ++b)
#pragma unroll
            for (int m = 0; m < 4; ++m)
#pragma unroll
                for (int n = 0; n < 2; ++n) acc[a][b][m][n] = (f32x4){0.f, 0.f, 0.f, 0.f};
    bf16x8 At[4][2], B0[2][2], B1[2][2];
    const char* cA = (const char*)g.A + (size_t)cur.pm * tstep; const char* cB = (const char*)g.Bt + (size_t)cur.pn * tstep;
    S.a_ready(cur);
    if constexpr (SP2) {
        PG8_STAGE(PG8_SB(0, 0), cB, voffB); PG8_STAGE(PG8_SB(0, 1), cB + hstep, voffB); PG8_STAGE(PG8_SA(0, 0), cA, voffA); PG8_STAGE(PG8_SA(0, 1), cA + hstep, voffA);
        if (wr == 1) PG8_BAR;
        PG8_WAIT_V(2); PG8_BAR;
        PG8_STAGE(PG8_SB(1, 0), cB + kstep, voffB); PG8_STAGE(PG8_SA(1, 0), cA + kstep, voffA); PG8_STAGE(PG8_SB(1, 1), cB + hstep + kstep, voffB);
        PG8_WAIT_V(6); PG8_BAR;
    } else {
        PG8_STAGE(PG8_SB(0, 0), cB, voffB); PG8_STAGE(PG8_SA(0, 0), cA, voffA); PG8_STAGE(PG8_SB(0, 1), cB + hstep, voffB); PG8_STAGE(PG8_SA(0, 1), cA + hstep, voffA);
        if (wr == 1) PG8_BAR;
        PG8_WAIT_V(4); PG8_BAR;
        PG8_STAGE(PG8_SB(1, 0), cB + kstep, voffB); PG8_STAGE(PG8_SA(1, 0), cA + kstep, voffA); PG8_STAGE(PG8_SB(1, 1), cB + hstep + kstep, voffB);
        PG8_WAIT_V(6); PG8_BAR;
    }
    for (;;) {
        const bool has_next = S.next(ui + 1, nxt);
        const char* nA = has_next ? (const char*)g.A + (size_t)nxt.pm * tstep : cA; const char* nB = has_next ? (const char*)g.Bt + (size_t)nxt.pn * tstep : cB;
        for (int t = 0; t < nt; t += 2) {
            const bool last = (t == nt - 2);
            const char* a1 = cA + (size_t)(t + 1) * kstep;
            const char* a2 = last ? nA : cA + (size_t)(t + 2) * kstep; const char* b2 = last ? nB : cB + (size_t)(t + 2) * kstep;
            const char* a3 = a2 + kstep; const char* b3 = b2 + kstep;
            if (last && has_next) S.a_ready(nxt);
            if constexpr (SP2) {
            PG8_LDB(B0, 0, 0); PG8_LDB(B1, 0, 1); PG8_SCHED; PG8_LDA(At, 0, 0); PG8_STAGE(PG8_SA(1, 1), a1 + hstep, voffA);
            PG8_WAIT_V(8); PG8_WAIT_L(0); PG8_BAR; PG8_MMA(0, 0, At, B0); PG8_MMA(0, 1, At, B1); PG8_BAR; PG8_SCHED;
            PG8_LDA(At, 0, 1); PG8_STAGE(PG8_SB(0, 0), b2, voffB); PG8_STAGE(PG8_SB(0, 1), b2 + hstep, voffB); PG8_STAGE(PG8_SA(0, 0), a2, voffA);
            PG8_WAIT_V(8); PG8_WAIT_L(0); PG8_BAR; PG8_MMA(1, 0, At, B0); PG8_MMA(1, 1, At, B1); PG8_BAR; PG8_SCHED;
            PG8_LDB(B0, 1, 0); PG8_LDB(B1, 1, 1); PG8_SCHED; PG8_LDA(At, 1, 0); PG8_STAGE(PG8_SA(0, 1), a2 + hstep, voffA);
            PG8_WAIT_V(8); PG8_WAIT_L(0); PG8_BAR; PG8_MMA(0, 0, At, B0); PG8_MMA(0, 1, At, B1); PG8_BAR; PG8_SCHED;
            PG8_LDA(At, 1, 1); PG8_STAGE(PG8_SB(1, 0), b3, voffB); PG8_STAGE(PG8_SB(1, 1), b3 + hstep, voffB); PG8_STAGE(PG8_SA(1, 0), a3, voffA);
            PG8_WAIT_V(8); PG8_WAIT_L(0); PG8_BAR; PG8_MMA(1, 0, At, B0); PG8_MMA(1, 1, At, B1); PG8_BAR; PG8_SCHED;
            } else {
            PG8_LDB(B0, 0, 0); PG8_SCHED; PG8_LDA(At, 0, 0); PG8_STAGE(PG8_SA(1, 1), a1 + hstep, voffA);
            PG8_WAIT_L(8); PG8_BAR; PG8_WAIT_L(0); PG8_MMA(0, 0, At, B0); PG8_BAR; PG8_SCHED;
            PG8_LDB(B1, 0, 1); PG8_STAGE(PG8_SB(0, 0), b2, voffB);
            PG8_BAR; PG8_WAIT_L(0); PG8_MMA(0, 1, At, B1); PG8_BAR;
            PG8_LDA(At, 0, 1); PG8_STAGE(PG8_SA(0, 0), a2, voffA);
            PG8_BAR; PG8_WAIT_L(0); PG8_MMA(1, 0, At, B0); PG8_BAR; PG8_SCHED;
            PG8_STAGE(PG8_SB(0, 1), b2 + hstep, voffB);
            PG8_WAIT_V(6); PG8_BAR; PG8_MMA(1, 1, At, B1); PG8_BAR;
            PG8_LDB(B0, 1, 0); PG8_SCHED; PG8_LDA(At, 1, 0); PG8_STAGE(PG8_SA(0, 1), a2 + hstep, voffA);
            PG8_WAIT_L(8); PG8_BAR; PG8_WAIT_L(0); PG8_MMA(0, 0, At, B0); PG8_BAR; PG8_SCHED;
            PG8_LDB(B1, 1, 1); PG8_STAGE(PG8_SB(1, 0), b3, voffB);
            PG8_BAR; PG8_WAIT_L(0); PG8_MMA(0, 1, At, B1); PG8_BAR;
            PG8_LDA(At, 1, 1); PG8_STAGE(PG8_SA(1, 0), a3, voffA);
            PG8_BAR; PG8_WAIT_L(0); PG8_MMA(1, 0, At, B0); PG8_BAR; PG8_SCHED;
            PG8_STAGE(PG8_SB(1, 1), b3 + hstep, voffB);
            PG8_WAIT_V(6); PG8_BAR; PG8_MMA(1, 1, At, B1); PG8_BAR;
            }
        }
        if constexpr (ALIGN_EPI) { if (wr == 0) PG8_BAR; }
        if constexpr (!Epi::AFTER_DRAIN) { E(acc, cur, wr, wc, fr, fq); S.done(cur); }
        if (!has_next) break;
#pragma unroll
        for (int a = 0; a < 2; ++a)
#pragma unroll
            for (int b = 0; b < 2; ++b)
#pragma unroll
                for (int m = 0; m < 4; ++m)
#pragma unroll
                    for (int n = 0; n < 2; ++n) acc[a][b][m][n] = (f32x4){0.f, 0.f, 0.f, 0.f};
        cur = nxt; cA = nA; cB = nB; ++ui;
        if constexpr (ALIGN_EPI) { if (wr == 1) PG8_BAR; }
    }
    PG8_WAIT_V(0);
    if constexpr (!ALIGN_EPI) { if (wr == 0) PG8_BAR; }
    PG8_BAR;
    if constexpr (Epi::AFTER_DRAIN) { E.fused(acc, cur, wr, wc, fr, fq, lds, wid, lane); S.done(cur); }
#undef PG8_SA
#undef PG8_SB
#undef PG8_STAGE
#undef PG8_LDA
#undef PG8_LDB
#undef PG8_MMA
#undef PG8_WAIT_V
#undef PG8_WAIT_L
#undef PG8_BAR
#undef PG8_SCHED
}
}

constexpr int DM = 1024, NPROMPT = 4 * 4096, NSAMPLE = 32 * 2048, MROWS = NPROMPT + NSAMPLE;
constexpr int QKVW = 3072, DFF = 2816, GUW = 2 * DFF;
constexpr float LOG2E = 1.4426950408889634f, RMS_EPS = 1e-6f;
constexpr size_t MiB = 1u << 20;
constexpr size_t WS_WIN = 2 * MiB, WS_WO = 8 * MiB, WS_WGU = 10 * MiB, WS_WD = 22 * MiB, WS_SS = 28 * MiB;
constexpr size_t WS_XN = 34 * MiB;
constexpr size_t WS_MIX = 194 * MiB;
constexpr size_t WS_QKV = 354 * MiB;
constexpr size_t WS_END = 834 * MiB;
constexpr int RING_BYTES = 131072, LDS_BYTES = 147456;

#define LAS __attribute__((address_space(3)))
typedef unsigned short bf16_t;
typedef short bf16x8 __attribute__((ext_vector_type(8)));
typedef short v4i16 __attribute__((ext_vector_type(4)));
typedef float f32x4 __attribute__((ext_vector_type(4)));
typedef unsigned u32x4 __attribute__((ext_vector_type(4)));
typedef unsigned u32x2 __attribute__((ext_vector_type(2)));

typedef float f32x2_t __attribute__((ext_vector_type(2))); typedef __bf16 bf16x2_t __attribute__((ext_vector_type(2)));
__device__ __forceinline__ unsigned cvtpk(float lo, float hi) { const f32x2_t v = {lo, hi}; const bf16x2_t b = __builtin_convertvector(v, bf16x2_t); return __builtin_bit_cast(unsigned, b); }
__device__ __forceinline__ float wave_sum(float v) {
#pragma unroll
    for (int o = 1; o < 64; o <<= 1) v += __shfl_xor(v, o);
    return v;
}

namespace att {
constexpr int VRS = 160, VBUF = 32 * VRS, KRS = 144, KBUF = 32 * KRS, WBUF = VBUF + KBUF;
constexpr int LDS_TAB = 8 * WBUF + 256, LDS_EXCH = 98304, LDS_GAIN = 106496;
constexpr float RESCALE_THR = 6.0f;
constexpr float M_INIT = -4096.f;
typedef float f32x2 __attribute__((ext_vector_type(2)));
struct Tile { f32x4 o[4]; float la; float m; };
__device__ __forceinline__ f32x4 mfma16(bf16x8 a, bf16x8 b, f32x4 c) { return __builtin_amdgcn_mfma_f32_16x16x32_bf16(a, b, c, 0, 0, 0); }
__device__ __forceinline__ v4i16 trd(LAS const unsigned char* p) { return __builtin_amdgcn_ds_read_tr16_b64_v4i16((LAS v4i16*)p); }
__device__ __forceinline__ void tile_init(Tile& t) {
#pragma unroll
    for (int dt = 0; dt < 4; ++dt) t.o[dt] = (f32x4){0.f, 0.f, 0.f, 0.f};
    t.la = 0.f; t.m = M_INIT;
}
__device__ __forceinline__ bf16x8 tile_softmax(Tile& t, float (&x)[8]) {
    float mx = fmaxf(fmaxf(fmaxf(x[0], x[1]), fmaxf(x[2], x[3])), fmaxf(fmaxf(x[4], x[5]), fmaxf(x[6], x[7])));
    { const auto r16 = __builtin_amdgcn_permlane16_swap(__float_as_uint(mx), __float_as_uint(mx), false, false); mx = fmaxf(__uint_as_float(r16[0]), __uint_as_float(r16[1])); }
    { const auto r32 = __builtin_amdgcn_permlane32_swap(__float_as_uint(mx), __float_as_uint(mx), false, false); mx = fmaxf(__uint_as_float(r32[0]), __uint_as_float(r32[1])); }
    if (__any(mx > RESCALE_THR)) {
        const float d = fmaxf(mx, 0.f), alpha = __builtin_amdgcn_exp2f(-d); t.m += d;
#pragma unroll
        for (int i = 0; i < 8; ++i) x[i] -= d;
#pragma unroll
        for (int dt = 0; dt < 4; ++dt) t.o[dt] = t.o[dt] * alpha;
        t.la = t.la * alpha;
    }
    float p[8];
#pragma unroll
    for (int i = 0; i < 8; ++i) p[i] = __builtin_amdgcn_exp2f(x[i]);
    t.la += ((p[0] + p[1]) + (p[2] + p[3])) + ((p[4] + p[5]) + (p[6] + p[7]));
    u32x4 pw; pw.x = cvtpk(p[0], p[1]); pw.y = cvtpk(p[2], p[3]); pw.z = cvtpk(p[4], p[5]); pw.w = cvtpk(p[6], p[7]);
    return __builtin_bit_cast(bf16x8, pw);
}
__device__ __forceinline__ void tile_pv(Tile& t, const bf16x8 pf, const bf16x8 (&vf)[4]) {
#pragma unroll
    for (int dt = 0; dt < 4; ++dt) t.o[dt] = mfma16(vf[dt], pf, t.o[dt]);
}
__device__ __forceinline__ void read_vfrags(bf16x8 (&vf)[4], LAS const unsigned char* vp) {
#pragma unroll
    for (int dt = 0; dt < 4; ++dt) { const v4i16 lo = trd(vp + dt * 32), hi = trd(vp + 16 * VRS + dt * 32);
        vf[dt] = (bf16x8){lo[0], lo[1], lo[2], lo[3], hi[0], hi[1], hi[2], hi[3]}; }
}
template <int SH, int NT, int QS, int CS, int NP> __device__ __forceinline__ void dil_run(Tile (&tl)[NT], const bf16x8 (&qf)[NT][2], const bf16_t* qkv_seq, int h, int T, int qb, float sld, LAS unsigned char* vbuf, int lane) {
    constexpr int D = 1 << SH;
    const int n = lane & 15, g = lane >> 4;
    const int lo_t = 64 - (qb >> SH), hi_t = 64 + ((T - 1 - qb) >> SH);
    float relb[NT], rlo[NT], rhi[NT];
#pragma unroll
    for (int c = 0; c < NT; ++c) { const int off = 64 + CS * c + QS * n; relb[c] = (float)(4 * g - off); rlo[c] = (float)max(-64, lo_t - off); rhi[c] = (float)min(64, hi_t - off); }
    const char* kvbase = (const char*)(qkv_seq + 2048 + h * 64 + (lane & 7) * 8);
    const int vrow = lane >> 3;
    LAS unsigned char* vw = vbuf + vrow * VRS + (lane & 7) * 16;
    LAS unsigned char* kw = vbuf + VBUF + vrow * KRS + (lane & 7) * 16;
    LAS const unsigned char* vp = vbuf + (4 * g + (n >> 2)) * VRS + (n & 3) * 8;
    LAS const unsigned char* kr = vbuf + VBUF + n * KRS + g * 16;
    u32x4 kA[4], vA[4];
#define DIL_LOAD(p, KN, VN) do { \
    _Pragma("unroll") for (int i = 0; i < 4; ++i) { const int tok = min(max(qb + D * (32 * (p) + vrow + 8 * i - 64), 0), T - 1); \
        const char* rp = kvbase + (unsigned)tok * (unsigned)(QKVW * 2); KN[i] = *(const u32x4*)rp; VN[i] = *(const u32x4*)(rp + 1024); } } while (0)
#define DIL_STEP(p, KN, VN) do { \
        _Pragma("unroll") for (int i = 0; i < 4; ++i) *(LAS u32x4*)(kw + 8 * i * KRS) = KN[i]; \
        bf16x8 kf[2][2]; \
        _Pragma("unroll") for (int tt = 0; tt < 2; ++tt) { kf[tt][0] = *(LAS const bf16x8*)(kr + tt * 16 * KRS); kf[tt][1] = *(LAS const bf16x8*)(kr + tt * 16 * KRS + 64); } \
        _Pragma("unroll") for (int i = 0; i < 4; ++i) *(LAS u32x4*)(vw + 8 * i * VRS) = VN[i]; \
        if ((p) + 1 <= p_hi) DIL_LOAD((p) + 1, KN, VN); \
        bf16x8 pf[NT]; bool act[NT]; \
        _Pragma("unroll") for (int c = 0; c < NT; ++c) { \
              \
            act[c] = (CS < 16) || (32 * (p) + 31 >= CS * c && 32 * (p) <= CS * c + 15 * QS + 128); pf[c] = (bf16x8){0, 0, 0, 0, 0, 0, 0, 0}; \
            if (act[c]) { const float nm = -tl[c].m; const f32x4 negm = (f32x4){nm, nm, nm, nm}; f32x4 s[2]; \
            _Pragma("unroll") for (int tt = 0; tt < 2; ++tt) { s[tt] = mfma16(kf[tt][0], qf[c][0], negm); s[tt] = mfma16(kf[tt][1], qf[c][1], s[tt]); } \
            const float relp = relb[c] + (float)(32 * (p)); float x[8]; \
            _Pragma("unroll") for (int tt = 0; tt < 2; ++tt) \
            _Pragma("unroll") for (int r = 0; r < 4; ++r) { const float rel = relp + (float)(16 * tt + r); const float xv = fmaf(fabsf(rel), sld, s[tt][r]); \
                    x[4 * tt + r] = (__builtin_amdgcn_fmed3f(rel, rlo[c], rhi[c]) == rel) ? xv : -INFINITY; } \
            pf[c] = tile_softmax(tl[c], x); } } \
        bf16x8 vf[4]; read_vfrags(vf, vp); \
        _Pragma("unroll") for (int c = 0; c < NT; ++c) if (act[c]) tile_pv(tl[c], pf[c], vf); } while (0)
    const int p_lo = max(0, lo_t >> 5), p_hi = min(NP - 1, hi_t >> 5);
    DIL_LOAD(p_lo, kA, vA);
#pragma unroll 1
    for (int p = p_lo; p <= p_hi; ++p) DIL_STEP(p, kA, vA);
#undef DIL_STEP
#undef DIL_LOAD
}

__device__ __forceinline__ void na_quad(Tile (&tl)[4], const bf16x8 (&qf)[4][2], const bf16_t* qkv_seq, int h, int r, int rows, int nb, LAS const unsigned char* rpbh, LAS unsigned char* vbuf, int lane) {
    const int n = lane & 15, g = lane >> 4;
    const int qcol = 16 * nb + n, kstart = min(max(16 * nb - 8, 0), 32), wstart = min(max(qcol - 8, 0), 48), wofs = wstart - kstart, cb = kstart - qcol + 15 + 4 * g;
    const int rs0 = min(max(r - 4, 0), rows - 8);
    int boff[8];
#pragma unroll
    for (int tt = 0; tt < 2; ++tt)
#pragma unroll
        for (int q = 0; q < 4; ++q) { const int kc = 16 * tt + 4 * g + q; boff[4 * tt + q] = ((unsigned)(kc - wofs) < 16u) ? 4 * (cb + 16 * tt + q) : 4 * 31; }
    const char* kvbase = (const char*)(qkv_seq + 512 + h * 64 + (lane & 7) * 8);
    const int vrow = lane >> 3;
    LAS unsigned char* vw = vbuf + vrow * VRS + (lane & 7) * 16;
    LAS unsigned char* kw = vbuf + VBUF + vrow * KRS + (lane & 7) * 16;
    LAS const unsigned char* vp = vbuf + (4 * g + (n >> 2)) * VRS + (n & 3) * 8;
    LAS const unsigned char* kfr = vbuf + VBUF + n * KRS + g * 16;
    u32x4 kA[4], vA[4];
#define NA_LOAD(kr, KN, VN) do { const int tb = min(rs0 + (kr), rows - 1) * 64 + kstart + vrow; \
    _Pragma("unroll") for (int i = 0; i < 4; ++i) { const char* rp = kvbase + (unsigned)(tb + 8 * i) * (unsigned)(QKVW * 2); KN[i] = *(const u32x4*)rp; VN[i] = *(const u32x4*)(rp + 1024); } } while (0)
#define NA_STEP(kr, KN, VN) do { \
        _Pragma("unroll") for (int i = 0; i < 4; ++i) *(LAS u32x4*)(kw + 8 * i * KRS) = KN[i]; \
        bf16x8 kf[2][2]; \
        _Pragma("unroll") for (int tt = 0; tt < 2; ++tt) { kf[tt][0] = *(LAS const bf16x8*)(kfr + tt * 16 * KRS); kf[tt][1] = *(LAS const bf16x8*)(kfr + tt * 16 * KRS + 64); } \
        _Pragma("unroll") for (int i = 0; i < 4; ++i) *(LAS u32x4*)(vw + 8 * i * VRS) = VN[i]; \
        if ((kr) + 1 < 11) NA_LOAD((kr) + 1, KN, VN); \
        bf16x8 pf[4]; bool act[4]; \
        _Pragma("unroll") for (int c = 0; c < 4; ++c) { const int rsc = min(max(r + c - 4, 0), rows - 8), kk = rs0 + (kr) - rsc; act[c] = (unsigned)kk < 8u; pf[c] = (bf16x8){0, 0, 0, 0, 0, 0, 0, 0}; \
            if (act[c]) {                             \
            const float nm = -tl[c].m; const f32x4 negm = (f32x4){nm, nm, nm, nm}; f32x4 s[2]; \
            _Pragma("unroll") for (int tt = 0; tt < 2; ++tt) { s[tt] = mfma16(kf[tt][0], qf[c][0], negm); s[tt] = mfma16(kf[tt][1], qf[c][1], s[tt]); } \
            LAS const unsigned char* bt = rpbh + (rs0 + (kr) - (r + c) + 7) * 128; float x[8]; \
            _Pragma("unroll") for (int i = 0; i < 8; ++i) x[i] = s[i >> 2][i & 3] + *(LAS const float*)(bt + boff[i]); \
            pf[c] = tile_softmax(tl[c], x); } } \
        bf16x8 vf[4]; read_vfrags(vf, vp); \
        _Pragma("unroll") for (int c = 0; c < 4; ++c) if (act[c]) tile_pv(tl[c], pf[c], vf); } while (0)
    NA_LOAD(0, kA, vA);
#pragma unroll 1
    for (int kr = 0; kr < 11; ++kr) NA_STEP(kr, kA, vA);
#undef NA_STEP
#undef NA_LOAD
}

__device__ __forceinline__ void regroup(Tile (&tl)[4], LAS unsigned char* buf, int lane) {
    const int n = lane & 15, g = lane >> 4;
    const int qs0 = (n >> 2) * 16 + 4 * (n & 3);
#pragma unroll
    for (int hf = 0; hf < 2; ++hf) {
#pragma unroll
        for (int c = 0; c < 4; ++c)
#pragma unroll
            for (int d2 = 0; d2 < 2; ++d2) *(LAS f32x4*)(buf + (qs0 + c) * 128 + (d2 * 16 + 4 * g) * 4) = tl[c].o[2 * hf + d2];
        if (hf == 0) {
#pragma unroll
            for (int c = 0; c < 4; ++c) { *(LAS float*)(buf + 8192 + ((qs0 + c) * 4 + g) * 4) = tl[c].la; *(LAS float*)(buf + 9216 + (qs0 + c) * 4) = tl[c].m; }
        }
#pragma unroll
        for (int c = 0; c < 4; ++c)
#pragma unroll
            for (int d2 = 0; d2 < 2; ++d2) tl[c].o[2 * hf + d2] = *(LAS const f32x4*)(buf + (c * 16 + n) * 128 + (d2 * 16 + 4 * g) * 4);
        if (hf == 0) {
#pragma unroll
            for (int c = 0; c < 4; ++c) { tl[c].la = *(LAS const float*)(buf + 8192 + ((c * 16 + n) * 4 + g) * 4); tl[c].m = *(LAS const float*)(buf + 9216 + (c * 16 + n) * 4); }
        }
    }
}

__device__ __forceinline__ void finish_tile(Tile& t, LAS float* exch, int h, LAS const float* gainp  , bf16_t* orow, int lane) {
    const int n = lane & 15, g = lane >> 4;
    float l = t.la; l += __shfl_xor(l, 16); l += __shfl_xor(l, 32);
    const float inv = 1.0f / l; float ss = 0.f;
#pragma unroll
    for (int dt = 0; dt < 4; ++dt) { t.o[dt] = t.o[dt] * inv; const f32x4 v = t.o[dt]; ss += (v[0] * v[0] + v[1] * v[1]) + (v[2] * v[2] + v[3] * v[3]); }
    ss += __shfl_xor(ss, 16); ss += __shfl_xor(ss, 32);
    if (g == 0) exch[h * 16 + n] = ss;
    __syncthreads();
    float tot = 0.f;
#pragma unroll
    for (int hh = 0; hh < 8; ++hh) tot += exch[hh * 16 + n];
    const float rinv = 1.0f / sqrtf(tot * (1.0f / 512.0f) + RMS_EPS);
#pragma unroll
    for (int dt = 0; dt < 4; ++dt) { const f32x4 v = t.o[dt] * *(LAS const f32x4*)(gainp + 16 * dt) * rinv; u32x2 w; w.x = cvtpk(v[0], v[1]); w.y = cvtpk(v[2], v[3]); *(u32x2*)(orow + 16 * dt) = w; }
}
__device__ __forceinline__ void load_q(bf16x8 (&qf)[2], const bf16_t* qp) { qf[0] = *(const bf16x8*)qp; qf[1] = *(const bf16x8*)(qp + 32); }
#define ATT_PATTERN_FENCE() asm volatile("s_waitcnt vmcnt(0)\n\tbuffer_inv sc1\n\ts_waitcnt vmcnt(0)" ::: "memory")

#ifndef REP_DIL
#define REP_DIL 1
#endif
#ifndef REP_NA
#define REP_NA 1
#endif
__device__ __forceinline__ void attn_phase(LAS unsigned char* lds, const bf16_t* qkv, bf16_t* mix, const float* rpb, const float* g_na, const float* g_dil, int vcu, int G, const int wave) {
    int lane_ = __builtin_amdgcn_mbcnt_hi(~0u, __builtin_amdgcn_mbcnt_lo(~0u, 0u)); asm volatile("" : "+v"(lane_)); const int lane = lane_ & 63, h = wave, tid = h * 64 + lane, n = lane & 15, g = lane >> 4;
    LAS float* tab = (LAS float*)(lds + LDS_TAB);
    { LAS float* gl = (LAS float*)(lds + LDS_GAIN); for (int i = tid; i < 1024; i += 512) gl[i] = (i < 512) ? g_dil[i] : g_na[i - 512]; }
    for (int i = tid; i < 8 * 16 * 32; i += 512) { const int c = i & 31, rr = (i >> 5) & 15, hh = i >> 9; tab[i] = (c < 31 && rr < 15) ? rpb[(hh * 15 + rr) * 31 + c] * LOG2E : -INFINITY; }
    __syncthreads();
    LAS unsigned char* vbuf = lds + h * WBUF;
    LAS float* exch = (LAS float*)(lds + LDS_EXCH);
    int par = 0;
    {
        const float sl2 = -LOG2E * __builtin_amdgcn_exp2f(-(float)(h + 1));
        for (int rep = 0; rep < REP_DIL; ++rep)
        for (int item = vcu; item < 1280; item += G) {
            const int jr = item / G, u0r = (item - jr * G) >> 2; const int unit = (G == 256) ? jr * 64 + (u0r & ~7) + ((u0r + jr) & 7) : (item >> 2); const int pg = item & 3;
            int sb, T, u0;
            if (unit < 64) { sb = (unit >> 4) * 4096; T = 4096; u0 = (unit & 15) * 256; } else { const int uu = unit - 64; sb = NPROMPT + (uu >> 3) * 2048; T = 2048; u0 = (uu & 7) * 256; }
            const bf16_t* qkv_seq = qkv + (size_t)sb * QKVW;
            const bf16_t* qcolp = qkv_seq + 1536 + h * 64 + 8 * g;
            {
                const int ub = u0 + pg; Tile tl[4]; bf16x8 qf[4][2];
#pragma unroll
                for (int c = 0; c < 4; ++c) { tile_init(tl[c]); load_q(qf[c], qcolp + (size_t)(ub + 4 * c + 16 * n) * QKVW); }
#pragma unroll
                for (int c = 0; c < 4; ++c) { Tile t1[1]; bf16x8 q1[1][2]; t1[0] = tl[c]; q1[0][0] = qf[c][0]; q1[0][1] = qf[c][1];
                    dil_run<4, 1, 1, 0, 5>(t1, q1, qkv_seq, h, T, ub + 4 * c, sl2 * 16.0f, vbuf, lane);
                    tl[c] = t1[0]; }
#pragma unroll
                for (int c = 0; c < 4; ++c) load_q(qf[c], qcolp + (size_t)(ub + 64 * c + 4 * n) * QKVW);
                regroup(tl, vbuf, lane);
                dil_run<2, 4, 1, 16, 6>(tl, qf, qkv_seq, h, T, ub, sl2 * 4.0f, vbuf, lane);
                dil_run<0, 4, 4, 64, 12>(tl, qf, qkv_seq, h, T, ub, sl2, vbuf, lane);
#pragma unroll
                for (int c = 0; c < 4; ++c) {
                    int lane2 = lane; asm volatile("" : "+v"(lane2));
                    const int n2 = lane2 & 15, g2 = lane2 >> 4;
                    finish_tile(tl[c], exch + par * 128, h, (LAS const float*)(lds + LDS_GAIN) + h * 64 + 4 * g2, mix + (size_t)(sb + ub + 64 * c + 4 * n2) * DM + 512 + h * 64 + 4 * g2, lane2);
                    par ^= 1; }
            }
        }
    }
    {
        int lane_n = __builtin_amdgcn_mbcnt_hi(~0u, __builtin_amdgcn_mbcnt_lo(~0u, 0u)); asm volatile("" : "+v"(lane_n)); const int lane = lane_n & 63, n = lane & 15, g = lane >> 4;
        LAS const unsigned char* rpbh = (LAS const unsigned char*)(tab + h * (16 * 32));
        for (int rep = 0; rep < REP_NA; ++rep)
        for (int item = vcu; item < 1280; item += G) {
            const int qd = item >> 2, nb = item & 3;
            int sb, rows, r;
            if (qd < 64) { sb = (qd >> 4) * 4096; rows = 64; r = (qd & 15) * 4; } else { const int ii = qd - 64; sb = NPROMPT + (ii >> 3) * 2048; rows = 32; r = (ii & 7) * 4; }
            const bf16_t* qkv_seq = qkv + (size_t)sb * QKVW;
            Tile tl[4]; bf16x8 qf[4][2];
#pragma unroll
            for (int c = 0; c < 4; ++c) { tile_init(tl[c]); load_q(qf[c], qkv_seq + (size_t)((r + c) * 64 + 16 * nb + n) * QKVW + h * 64 + 8 * g); }
            na_quad(tl, qf, qkv_seq, h, r, rows, nb, rpbh, vbuf, lane);
#pragma unroll
            for (int c = 0; c < 4; ++c) { int lane2 = lane; asm volatile("" : "+v"(lane2)); const int n2 = lane2 & 15, g2 = lane2 >> 4;
                finish_tile(tl[c], exch + par * 128, h, (LAS const float*)(lds + LDS_GAIN) + 512 + h * 64 + 4 * g2, mix + (size_t)(sb + (r + c) * 64 + 16 * nb + n2) * DM + h * 64 + 4 * g2, lane2); par ^= 1; }
        }
    }
    __syncthreads();
}
}

__device__ __forceinline__ void transpose_item(const float* W, int K, int N, bf16_t* WT, int k0, int n0, int dst_row0, const float* kgain, float sn, LAS float* scr, int lane) {
#pragma unroll
    for (int i = 0; i < 32; ++i) { const int kk = 2 * i + (lane >> 5); float v = W[(size_t)(k0 + kk) * N + n0 + (lane & 31)] * sn; if (kgain) v *= kgain[k0 + kk]; scr[kk * 33 + (lane & 31)] = v; }
    asm volatile("s_waitcnt lgkmcnt(0)" ::: "memory");
    const int c = lane & 7;
#pragma unroll
    for (int j = 0; j < 4; ++j) { const int nn = (lane >> 3) + 8 * j; const LAS float* s = scr + (8 * c) * 33 + nn;
        u32x4 o; o.x = cvtpk(s[0 * 33], s[1 * 33]); o.y = cvtpk(s[2 * 33], s[3 * 33]); o.z = cvtpk(s[4 * 33], s[5 * 33]); o.w = cvtpk(s[6 * 33], s[7 * 33]);
        *(u32x4*)(WT + (size_t)(dst_row0 + nn) * K + k0 + 8 * c) = o; }
    asm volatile("s_waitcnt lgkmcnt(0)" ::: "memory");
}
template <bool TOBF> __device__ __forceinline__ void rms_row(const float* xrow, const float* gain, void* orow, int lane) {
    const f32x4* xr = (const f32x4*)xrow + lane; const f32x4* gr = (const f32x4*)gain + lane;
    f32x4 v[4]; float s = 0.f;
#pragma unroll
    for (int j = 0; j < 4; ++j) { v[j] = xr[64 * j]; s += (v[j][0] * v[j][0] + v[j][1] * v[j][1]) + (v[j][2] * v[j][2] + v[j][3] * v[j][3]); }
    const float rinv = 1.0f / sqrtf(wave_sum(s) * (1.0f / 1024.0f) + RMS_EPS);
#pragma unroll
    for (int j = 0; j < 4; ++j) { const f32x4 o = v[j] * rinv * gr[64 * j];
        if (TOBF) { u32x2 w; w.x = cvtpk(o[0], o[1]); w.y = cvtpk(o[2], o[3]); ((u32x2*)orow)[64 * j + lane] = w; }
        else ((f32x4*)orow)[64 * j + lane] = o; }
}

template <bool TOBF> __device__ __forceinline__ void rms_rows(const float* p0, const float* p1, const float* gain, void* obase, int gw, int NGW, int lane) {
    f32x4 gr[4], a[4], b[4], c[4];
#pragma unroll
    for (int j = 0; j < 4; ++j) gr[j] = ((const f32x4*)gain)[64 * j + lane];
#define RR_LOAD(dst, mm) do { const int m_ = min((mm), MROWS - 1); const f32x4* xr_ = (const f32x4*)(m_ < NPROMPT ? p0 + (size_t)m_ * DM : p1 + (size_t)(m_ - NPROMPT) * DM) + lane; \
    _Pragma("unroll") for (int j = 0; j < 4; ++j) dst[j] = xr_[64 * j]; } while (0)
    RR_LOAD(a, gw); RR_LOAD(b, gw + NGW);
    for (int m = gw; m < MROWS; m += NGW) {
        RR_LOAD(c, m + 2 * NGW);
        float s = 0.f;
#pragma unroll
        for (int j = 0; j < 4; ++j) s += (a[j][0] * a[j][0] + a[j][1] * a[j][1]) + (a[j][2] * a[j][2] + a[j][3] * a[j][3]);
        const float rinv = 1.0f / sqrtf(wave_sum(s) * (1.0f / 1024.0f) + RMS_EPS);
#pragma unroll
        for (int j = 0; j < 4; ++j) { const f32x4 o = a[j] * rinv * gr[j];
            if (TOBF) { u32x2 w; w.x = cvtpk(o[0], o[1]); w.y = cvtpk(o[2], o[3]); ((u32x2*)obase)[(size_t)m * 256 + 64 * j + lane] = w; }
            else ((f32x4*)obase)[(size_t)m * 256 + 64 * j + lane] = o; }
#pragma unroll
        for (int j = 0; j < 4; ++j) { a[j] = b[j]; b[j] = c[j]; }
    }
#undef RR_LOAD
}

__device__ __forceinline__ void final_rows(const bf16_t* y, const float* ss, const float* gain, float* out, int gw, int NGW, int lane) {
    f32x4 gr[4]; u32x2 a[4], b[4], c[4]; float sa, sb, sc;
#pragma unroll
    for (int j = 0; j < 4; ++j) gr[j] = ((const f32x4*)gain)[64 * j + lane];
#define FR_LOAD(dst, sd, mm) do { const int m_ = min((mm), MROWS - 1); const u32x2* yr_ = (const u32x2*)(y + (size_t)m_ * DM) + lane; \
    _Pragma("unroll") for (int j = 0; j < 4; ++j) dst[j] = yr_[64 * j]; sd = ss[(size_t)m_ * 16 + (lane & 15)]; } while (0)
    FR_LOAD(a, sa, gw); FR_LOAD(b, sb, gw + NGW);
    for (int m = gw; m < MROWS; m += NGW) {
        FR_LOAD(c, sc, m + 2 * NGW);
        float t = sa; t += __shfl_xor(t, 1); t += __shfl_xor(t, 2); t += __shfl_xor(t, 4); t += __shfl_xor(t, 8);
        const float rinv = 1.0f / sqrtf(t * (1.0f / 1024.0f) + RMS_EPS);
#pragma unroll
        for (int j = 0; j < 4; ++j) { const f32x4 v = (f32x4){__uint_as_float(a[j].x << 16), __uint_as_float(a[j].x & 0xffff0000u), __uint_as_float(a[j].y << 16), __uint_as_float(a[j].y & 0xffff0000u)};
            ((f32x4*)out)[(size_t)m * 256 + 64 * j + lane] = v * rinv * gr[j]; }
#pragma unroll
        for (int j = 0; j < 4; ++j) { a[j] = b[j]; b[j] = c[j]; }
        sa = sb; sb = sc;
    }
#undef FR_LOAD
}

#define XB_TMO      128
#define XB_XCNT(j)  (256  + 64 * (j))
#define XB_XSUB(j)  (1280 + 64 * (j))
#define XB_XGEN(j)  (2304 + 64 * (j))
#define XB_TOP      3328
#define XB_TOPGEN   3392
#define XCD_BAR_WORDS 3456
#define XB_SPIN_CAP (1u << 18)

__device__ __forceinline__ unsigned xb_ld(unsigned* p)              { return __hip_atomic_load(p, __ATOMIC_RELAXED, __HIP_MEMORY_SCOPE_AGENT); }
__device__ __forceinline__ unsigned xb_add(unsigned* p, unsigned v) { return __hip_atomic_fetch_add(p, v, __ATOMIC_RELAXED, __HIP_MEMORY_SCOPE_AGENT); }
__device__ __forceinline__ unsigned xb_xcc_id() { return (unsigned)__builtin_amdgcn_s_getreg((3 << 11) | 20) & 0xFu; }
#define XB_SPIN(cond, bar) do { unsigned _sp = 0; while (cond) { __builtin_amdgcn_s_sleep(1); \
    if ((++_sp & 255u) == 0u) { if (xb_ld(&(bar)[XB_TMO])) break; if (_sp > XB_SPIN_CAP) { atomicAdd(&(bar)[XB_TMO], 1u); break; } } } } while (0)

struct XcdBarrier {
    unsigned* bar; unsigned x;
    volatile LAS unsigned* st;
};

__device__ __forceinline__ XcdBarrier xcd_barrier_post(unsigned* bar, volatile LAS unsigned* st) {
    XcdBarrier b; b.bar = bar; b.x = xb_xcc_id(); b.st = st;
    if (threadIdx.x == 0) (void)xb_add(&bar[XB_XCNT(b.x)], 1u);
    return b;
}
__device__ __forceinline__ void xcd_barrier_complete(unsigned* bar, unsigned x, unsigned& nloc, unsigned& nx) {
    const unsigned G = gridDim.x * gridDim.y * gridDim.z;
    unsigned sum, cnt, mine, sp = 0u;
    for (;;) {
        sum = 0u; cnt = 0u; mine = 0u;
#pragma unroll
        for (unsigned j = 0; j < 16; ++j) { const unsigned c = xb_ld(&bar[XB_XCNT(j)]); sum += c; cnt += (c > 0u) ? 1u : 0u; mine = (j == x) ? c : mine; }
        if (sum == G) break;
        __builtin_amdgcn_s_sleep(1);
        if ((++sp & 255u) == 0u) { if (xb_ld(&bar[XB_TMO])) break; if (sp > XB_SPIN_CAP) { atomicAdd(&bar[XB_TMO], 1u); break; } }
    }
    nloc = mine > 0u ? mine : 1u; nx = cnt > 0u ? cnt : 1u;
}

__device__ __forceinline__ void xcd_barrier(const XcdBarrier& b, const int wave) {
    asm volatile("s_waitcnt vmcnt(0)" ::: "memory");
    __syncthreads();
    if (wave == 0 && __builtin_amdgcn_mbcnt_hi(~0u, __builtin_amdgcn_mbcnt_lo(~0u, 0u)) == 0u) {
        unsigned* bar = b.bar;
        __builtin_amdgcn_s_waitcnt(0);
        unsigned nloc = b.st[0], nx = b.st[1];
        if (nloc == 0u) { xcd_barrier_complete(bar, b.x, nloc, nx); b.st[0] = nloc; b.st[1] = nx; }
        const unsigned old = xb_add(&bar[XB_XSUB(b.x)], 1u);
        const unsigned gen = old / nloc;
        if (old + 1u == (gen + 1u) * nloc) {
            __builtin_amdgcn_fence(__ATOMIC_RELEASE, "agent");
            asm volatile("s_waitcnt vmcnt(0)" ::: "memory");
            const unsigned og = xb_add(&bar[XB_TOP], 1u);
            const unsigned tg = og / nx;
            if (og + 1u == (tg + 1u) * nx) xb_add(&bar[XB_TOPGEN], 1u);
            else XB_SPIN(xb_ld(&bar[XB_TOPGEN]) == tg, bar);
            __builtin_amdgcn_fence(__ATOMIC_ACQUIRE, "agent");
            xb_add(&bar[XB_XGEN(b.x)], 1u);
            asm volatile("s_waitcnt vmcnt(0)" ::: "memory");
        } else {
            XB_SPIN(xb_ld(&bar[XB_XGEN(b.x)]) == gen, bar);
            __builtin_amdgcn_fence(__ATOMIC_ACQUIRE, "agent");
            asm volatile("s_waitcnt vmcnt(0)" ::: "memory");
        }
    }
    __syncthreads();
}

struct Args { const float* in[13]; float* out; unsigned char* ws; };

#define GRID_SYNC() do { asm volatile("s_waitcnt vmcnt(0)" ::: "memory"); grid.sync(); asm volatile("buffer_inv sc1\n\ts_waitcnt vmcnt(0)" ::: "memory"); } while (0)
#define XSYNC() xcd_barrier(xbar, wave)
__global__ void __launch_bounds__(512, 2) hymba_fwd(Args a) {
    extern __shared__ __attribute__((aligned(16))) unsigned char lds_raw[];
    cg::grid_group grid = cg::this_grid();
    LAS unsigned char* lds = (LAS unsigned char*)lds_raw;
    const int wave = __builtin_amdgcn_readfirstlane((int)threadIdx.x >> 6);
    volatile LAS unsigned* xst = (volatile LAS unsigned*)(lds + RING_BYTES + 64);
    if (threadIdx.x < 2) xst[threadIdx.x] = 0u;
    __syncthreads();
    const XcdBarrier xbar = xcd_barrier_post((unsigned*)(a.ws + 4096), xst);
    const int G = gridDim.x, bx = blockIdx.x, vcu = (G % 8 == 0) ? (bx % 8) * (G / 8) + bx / 8 : bx;
    unsigned char* ws = a.ws;
    bf16_t* Win_t = (bf16_t*)(ws + WS_WIN); bf16_t* Wo_t = (bf16_t*)(ws + WS_WO); bf16_t* Wgu_t = (bf16_t*)(ws + WS_WGU); bf16_t* Wd_t = (bf16_t*)(ws + WS_WD);
    float* SS = (float*)(ws + WS_SS); bf16_t* XN = (bf16_t*)(ws + WS_XN); bf16_t* MIX = (bf16_t*)(ws + WS_MIX); bf16_t* QKV = (bf16_t*)(ws + WS_QKV); bf16_t* HB = (bf16_t*)(ws + WS_QKV);
    const float* xp = a.in[0]; const float* xs = a.in[1];
    const int gw = vcu * 8 + wave, NGW = G * 8;

#ifndef REP_P0
#define REP_P0 1
#endif
    for (int rep0 = 0; rep0 < REP_P0; ++rep0) {
        int lane = __builtin_amdgcn_mbcnt_hi(~0u, __builtin_amdgcn_mbcnt_lo(~0u, 0u)); asm volatile("" : "+v"(lane)); lane &= 63;
        LAS float* scr = (LAS float*)(lds + wave * 16384);
        constexpr int I_IN = 16 * 96, I_O = 16 * 32, I_G = 16 * 88, I_D = 44 * 32, NITEMS = I_IN + I_O + 2 * I_G + I_D;
        for (int it = gw; it < NITEMS; it += NGW) {
            int r = it;
            if (r < I_IN) { const int kb = r / 96, nb = r % 96, n0 = 32 * nb; const float sn = (n0 < 512 || (n0 >= 1536 && n0 < 2048)) ? 0.125f * LOG2E : 1.0f;
                transpose_item(a.in[2], 1024, QKVW, Win_t, 64 * kb, n0, n0, nullptr, sn, scr, lane); continue; } r -= I_IN;
            if (r < I_O) { const int kb = r / 32, nb = r % 32; transpose_item(a.in[7], 1024, 1024, Wo_t, 64 * kb, 32 * nb, 32 * nb, nullptr, 1.0f, scr, lane); continue; } r -= I_O;
            if (r < 2 * I_G) { const int up = r >= I_G ? 1 : 0; if (up) r -= I_G; const int kb = r / 88, nb = r % 88, n0 = 32 * nb;
                transpose_item(up ? a.in[10] : a.in[9], 1024, DFF, Wgu_t, 64 * kb, n0, (n0 >> 7) * 256 + (n0 & 127) + up * 128, a.in[8], 1.0f, scr, lane); continue; } r -= 2 * I_G;
            { const int kb = r / 32, nb = r % 32; transpose_item(a.in[11], DFF, 1024, Wd_t, 64 * kb, 32 * nb, 32 * nb, nullptr, 1.0f, scr, lane); }
        }
        rms_rows<true>(xp, xs, a.in[4], XN, gw, NGW, lane);
    }
    GRID_SYNC();
#ifdef REP_SYNC
    for (int rs_ = 0; rs_ < REP_SYNC; ++rs_) GRID_SYNC();
#endif
    {
        pg8::Gemm g{XN, Win_t, MROWS, QKVW, 1024}; pg8::StaticOrder S; S.init(MROWS, QKVW, G, bx);
        pg8::EpiStoreBf16 E{QKV, QKVW};
        pg8::gemm_phase<pg8::EpiStoreBf16, pg8::StaticOrder, true, true>(lds, g, S, E, wave);
#ifdef REP_P1
        pg8::gemm_phase<pg8::EpiStoreBf16, pg8::StaticOrder, true, true>(lds, g, S, E, wave);
#endif
    }
    XSYNC();
    att::attn_phase(lds, QKV, MIX, a.in[3], a.in[5], a.in[6], vcu, G, wave);
    XSYNC();
    {
        pg8::Gemm g{MIX, Wo_t, MROWS, 1024, 1024}; pg8::StaticOrder S; S.init(MROWS, 1024, G, bx);
        pg8::EpiResid<true> E{xp, xs, NPROMPT, nullptr, XN, SS};
        pg8::gemm_phase<pg8::EpiResid<true>, pg8::StaticOrder, true, true>(lds, g, S, E, wave);
#ifdef REP_P3
        pg8::gemm_phase<pg8::EpiResid<true>, pg8::StaticOrder, true, true>(lds, g, S, E, wave);
#endif
    }
    XSYNC();
    {
        pg8::Gemm g{XN, Wgu_t, MROWS, GUW, 1024}; pg8::StaticOrder S; S.init(MROWS, GUW, G, bx);
        pg8::EpiSwiglu E{HB, DFF, SS, (LAS float*)(lds + RING_BYTES + 1024), -1};
        pg8::gemm_phase<pg8::EpiSwiglu, pg8::StaticOrder, true, true>(lds, g, S, E, wave);
#ifdef REP_P4
        pg8::gemm_phase<pg8::EpiSwiglu, pg8::StaticOrder, true, true>(lds, g, S, E, wave);
#endif
    }
    XSYNC();
    {
        pg8::Gemm g{HB, Wd_t, MROWS, 1024, DFF}; pg8::StaticOrder S; S.init(MROWS, 1024, G, bx);
        pg8::EpiResid<false> E{nullptr, nullptr, 0, XN, MIX, SS};
        pg8::gemm_phase<pg8::EpiResid<false>, pg8::StaticOrder, true, true>(lds, g, S, E, wave);
    }
    XSYNC();
    { int l6 = __builtin_amdgcn_mbcnt_hi(~0u, __builtin_amdgcn_mbcnt_lo(~0u, 0u)); asm volatile("" : "+v"(l6)); l6 &= 63;
      final_rows(MIX, SS, a.in[12], a.out, gw, NGW, l6); }
}

extern "C" void kernel_launch(void* const* d_in, const int* in_sizes, int n_in, void* d_out, int out_size, void* d_ws, size_t ws_size, hipStream_t stream) {
    static int grid = 0;
    if (grid == 0) {
        if (n_in != 13 || out_size != MROWS * DM || ws_size < WS_END) { fprintf(stderr, "kernel_launch: unexpected shapes (n_in %d out %d ws %zu)\n", n_in, out_size, ws_size); grid = -1; return; }
        int dev = 0, cus = 0, per_cu = 0;
        hipGetDevice(&dev); hipDeviceGetAttribute(&cus, hipDeviceAttributeMultiprocessorCount, dev);
        if (hipFuncSetAttribute((const void*)hymba_fwd, hipFuncAttributeMaxDynamicSharedMemorySize, LDS_BYTES) != hipSuccess) { fprintf(stderr, "kernel_launch: hipFuncSetAttribute failed\n"); }
        if (hipOccupancyMaxActiveBlocksPerMultiprocessor(&per_cu, (const void*)hymba_fwd, 512, LDS_BYTES) != hipSuccess || per_cu < 1) { fprintf(stderr, "kernel_launch: occupancy query says %d\n", per_cu); per_cu = 1; }
        (void)hipGetLastError();
        grid = cus * per_cu;
    }
    if (grid < 0) return;
    if (hipMemsetAsync(d_ws, 0, 32768, stream) != hipSuccess) { fprintf(stderr, "kernel_launch: memset of the barrier words failed\n"); return; }
    Args a{};
    for (int i = 0; i < 13; ++i) a.in[i] = (const float*)d_in[i];
    a.out = (float*)d_out; a.ws = (unsigned char*)d_ws;
    void* args[] = {&a};
    hipError_t e = hipLaunchCooperativeKernel((const void*)hymba_fwd, dim3(grid), dim3(512), args, LDS_BYTES, stream);
    if (e != hipSuccess) fprintf(stderr, "cooperative launch failed: %s (grid %d)\n", hipGetErrorString(e), grid);
}
```

```cpp
#include <hip/hip_runtime.h>
#include <hip/hip_cooperative_groups.h>
#include <cstdio>
#include <cstdint>
namespace cg = cooperative_groups;
namespace pg8 {
#define PG8_LAS __attribute__((address_space(3)))
typedef unsigned short bf16_t;
typedef short bf16x8 __attribute__((ext_vector_type(8)));
typedef float f32x4 __attribute__((ext_vector_type(4)));
typedef unsigned u32x4 __attribute__((ext_vector_type(4)));
constexpr int BM = 256, BK = 64, HALF = 128, HTB = HALF * BK * 2  , STAGE_BYTES = 8 * HTB, NXCD = 8, WGM = 8;

__host__ __device__ __forceinline__ int lds_byte(int r, int c) { const int st = (r >> 4) * 2 + (c >> 5), rr = r & 15, cc = c & 31, ob = rr * 64 + cc * 2; return st * 1024 + (ob ^ (((ob >> 9) & 1) << 5)); }
__host__ __device__ __forceinline__ void stage_rc(int b, int& R, int& C) { const int st = b / 1024, sb = b % 1024, swz = sb ^ (((sb >> 9) & 1) << 5); R = (st >> 1) * 16 + swz / 64; C = (st & 1) * 32 + (swz % 64) / 2; }
__host__ __device__ __forceinline__ int perm32(int rho) { const int n = rho >> 4, i = rho & 15; return 8 * (i >> 2) + 4 * n + (i & 3); }

struct Unit { int pm, pn; };
struct Gemm { const bf16_t* A; const bf16_t* Bt; int M, N, K; };

struct StaticOrder {
    int nM, nN, nwg, G, c;
    __host__ __device__ void init(int M, int N, int G_, int c_) { nM = M / BM; nN = N / BM; nwg = nM * nN; G = G_; c = c_; }
    __host__ __device__ bool next(int i, Unit& u) const {
        const long L = (long)i * G + c; if (L >= nwg) return false;
        int wgid = (int)L; { const int q = nwg / NXCD, r = nwg % NXCD, xcd = wgid % NXCD, off = wgid / NXCD; wgid = (xcd < r ? xcd * (q + 1) : r * (q + 1) + (xcd - r) * q) + off; }
        const int nig = WGM * nN, gid = wgid / nig, fm = gid * WGM, gsz = (nM - fm) < WGM ? (nM - fm) : WGM;
        u.pm = fm + ((wgid % nig) % gsz); u.pn = (wgid % nig) / gsz; return true;
    }
    __device__ __forceinline__ void a_ready(const Unit&) const {}
    __device__ __forceinline__ void done(const Unit&) const {}
};


typedef float f32x2_t __attribute__((ext_vector_type(2))); typedef __bf16 bf16x2_t __attribute__((ext_vector_type(2)));
__device__ __forceinline__ unsigned cvt_pk_bf16(float lo, float hi) { const f32x2_t v = {lo, hi}; const bf16x2_t b = __builtin_convertvector(v, bf16x2_t); return __builtin_bit_cast(unsigned, b); }
typedef unsigned u32x2 __attribute__((ext_vector_type(2)));

struct EpiStoreBf16 {
    static constexpr bool PERM = true, AFTER_DRAIN = false;
    bf16_t* O; int ldc;
    __device__ __forceinline__ void operator()(const f32x4 (&acc)[2][2][4][2], const Unit& u, int wr, int wc, int fr, int fq) const {
        const int row0 = u.pm * BM + wr * 64 + fr, col0 = u.pn * BM + wc * 32 + 8 * fq;
#pragma unroll
        for (int ai = 0; ai < 2; ++ai)
#pragma unroll
            for (int m = 0; m < 4; ++m) { bf16_t* rowp = O + (size_t)(row0 + ai * HALF + m * 16) * ldc + col0;
#pragma unroll
                for (int bj = 0; bj < 2; ++bj) { const f32x4 v0 = acc[ai][bj][m][0], v1 = acc[ai][bj][m][1];
                    u32x4 w; w.x = cvt_pk_bf16(v0[0], v0[1]); w.y = cvt_pk_bf16(v0[2], v0[3]); w.z = cvt_pk_bf16(v1[0], v1[1]); w.w = cvt_pk_bf16(v1[2], v1[3]);
                    *(u32x4*)(rowp + bj * HALF) = w; } }
    }
};

template <bool FIRST> struct EpiResid {
    static constexpr bool PERM = false, AFTER_DRAIN = false;
    const float* xp; const float* xs; int split; const bf16_t* rb; bf16_t* ob; float* ss;
    __device__ __forceinline__ void operator()(const f32x4 (&acc)[2][2][4][2], const Unit& u, int wr, int wc, int fr, int fq) const {
        const int row0 = u.pm * BM + wr * 64 + fr, col0 = u.pn * BM + wc * 32 + 4 * fq;
        u32x2 rbv[2][4][2][2];
        if (!FIRST) {
#pragma unroll
            for (int ai = 0; ai < 2; ++ai)
#pragma unroll
                for (int m = 0; m < 4; ++m) { const bf16_t* rbp = rb + (size_t)(row0 + ai * HALF + m * 16) * 1024 + col0;
#pragma unroll
                    for (int bj = 0; bj < 2; ++bj)
#pragma unroll
                        for (int n = 0; n < 2; ++n) rbv[ai][m][bj][n] = *(const u32x2*)(rbp + bj * HALF + n * 16); }
        }
#pragma unroll
        for (int ai = 0; ai < 2; ++ai) {
            f32x4 rx[4][2][2];
            if (FIRST) {
#pragma unroll
                for (int m = 0; m < 4; ++m) { const int row = row0 + ai * HALF + m * 16; const float* rp = (row < split ? xp + (size_t)row * 1024 : xs + (size_t)(row - split) * 1024) + col0;
#pragma unroll
                    for (int bj = 0; bj < 2; ++bj)
#pragma unroll
                        for (int n = 0; n < 2; ++n) rx[m][bj][n] = *(const f32x4*)(rp + bj * HALF + n * 16); }
            }
#pragma unroll
            for (int m = 0; m < 4; ++m) { const int row = row0 + ai * HALF + m * 16;
                bf16_t* op = ob + (size_t)row * 1024 + col0;
                float s = 0.f;
#pragma unroll
                for (int bj = 0; bj < 2; ++bj)
#pragma unroll
                    for (int n = 0; n < 2; ++n) { const int c = bj * HALF + n * 16; f32x4 r;
                        if (FIRST) r = rx[m][bj][n];
                        else { const u32x2 w = rbv[ai][m][bj][n]; r = (f32x4){__uint_as_float(w.x << 16), __uint_as_float(w.x & 0xffff0000u), __uint_as_float(w.y << 16), __uint_as_float(w.y & 0xffff0000u)}; }
                        const f32x4 v = r + acc[ai][bj][m][n];
                        u32x2 w; w.x = cvt_pk_bf16(v[0], v[1]); w.y = cvt_pk_bf16(v[2], v[3]); *(u32x2*)(op + c) = w;
                        s += (v[0] * v[0] + v[1] * v[1]) + (v[2] * v[2] + v[3] * v[3]); }
                s += __shfl_xor(s, 16); s += __shfl_xor(s, 32); if (fq == 0) ss[(size_t)row * 16 + u.pn * 4 + wc] = s; }
        }
    }
};

struct EpiSwiglu {
    static constexpr bool PERM = true, AFTER_DRAIN = false;
    bf16_t* H; int ldh; const float* ss; PG8_LAS float* rtab;
    mutable int pm_c;
    __device__ __forceinline__ void operator()(const f32x4 (&acc)[2][2][4][2], const Unit& u, int wr, int wc, int fr, int fq) const {
        const int row0 = u.pm * BM + wr * 64 + fr, f0 = u.pn * HALF + wc * 32 + 8 * fq;
        PG8_LAS float* rt = rtab + (wr * 4 + wc) * 128;
        if (u.pm != pm_c) {
            pm_c = u.pm;
            const int L = fq * 16 + fr;
#pragma unroll
            for (int k = 0; k < 2; ++k) { const int t = L + 64 * k, row = u.pm * BM + wr * 64 + (t >> 6) * HALF + (t & 63);
                const f32x4* sp = (const f32x4*)(ss + (size_t)row * 16); const f32x4 a = sp[0], b = sp[1], c = sp[2], d = sp[3];
                const float tot = ((a[0] + a[1]) + (a[2] + a[3])) + ((b[0] + b[1]) + (b[2] + b[3])) + ((c[0] + c[1]) + (c[2] + c[3])) + ((d[0] + d[1]) + (d[2] + d[3]));
                rt[t] = 1.0f / sqrtf(tot * (1.0f / 1024.0f) + 1e-6f); }
        }
#pragma unroll
        for (int ai = 0; ai < 2; ++ai)
#pragma unroll
            for (int m = 0; m < 4; ++m) { const int row = row0 + ai * HALF + m * 16;
                const float rinv = rt[ai * 64 + m * 16 + fr];
                float hv[8];
#pragma unroll
                for (int n = 0; n < 2; ++n)
#pragma unroll
                    for (int i = 0; i < 4; ++i) { const float g = acc[ai][0][m][n][i] * rinv, up = acc[ai][1][m][n][i] * rinv;
                        const float e = __builtin_amdgcn_exp2f(g * -1.4426950408889634f); hv[n * 4 + i] = g * __builtin_amdgcn_rcpf(1.0f + e) * up; }
                u32x4 w; w.x = cvt_pk_bf16(hv[0], hv[1]); w.y = cvt_pk_bf16(hv[2], hv[3]); w.z = cvt_pk_bf16(hv[4], hv[5]); w.w = cvt_pk_bf16(hv[6], hv[7]);
                *(u32x4*)(H + (size_t)row * ldh + f0) = w; }
    }
};

template <class Epi, class Sched, bool ALIGN_EPI = false, bool SP2 = false>
__device__ __forceinline__ void gemm_phase(PG8_LAS unsigned char* lds, const Gemm g, const Sched& S, const Epi& E, const int wid_in) {
    int lane_ = __builtin_amdgcn_mbcnt_hi(~0u, __builtin_amdgcn_mbcnt_lo(~0u, 0u)); asm volatile("" : "+v"(lane_)); const int wid = wid_in, lane = lane_ & 63, tid = wid * 64 + lane, wr = wid >> 2, wc = wid & 3, fr = lane & 15, fq = lane >> 4;
    const int K = g.K, nt = K / BK;
    unsigned voffA[2], voffB[2];
#pragma unroll
    for (int i = 0; i < 2; ++i) { int R, C; stage_rc(tid * 16 + i * 8192, R, C); const int Rb = Epi::PERM ? ((R & ~31) + perm32(R & 31)) : R;
        voffA[i] = (unsigned)(R * K + C) * 2u; voffB[i] = (unsigned)(Rb * K + C) * 2u; }
    const size_t kstep = (size_t)(BK * 2);
    const size_t hstep = (size_t)HALF * K * 2;
    const size_t tstep = 2 * hstep;
    const unsigned ldsw = (unsigned)wid * 1024u;
    const int aoff = lds_byte(wr * 64 + fr, fq * 8), boff = lds_byte(wc * 32 + fr, fq * 8);
#define PG8_SA(b, h) (((b) * 2 + (h)) * HTB)
#define PG8_SB(b, h) ((4 + (b) * 2 + (h)) * HTB)
#define PG8_STAGE(bufoff, gbase, voff) do { _Pragma("unroll") for (int _i = 0; _i < 2; ++_i) \
        __builtin_amdgcn_global_load_lds((const unsigned*)((const char*)(gbase) + (voff)[_i]), (PG8_LAS unsigned*)(lds + (bufoff) + ldsw + _i * 8192), 16, 0, 0); } while (0)
#define PG8_LDA(dst, b, h) do { _Pragma("unroll") for (int m = 0; m < 4; ++m) _Pragma("unroll") for (int k = 0; k < 2; ++k) dst[m][k] = *(const PG8_LAS bf16x8*)(lds + PG8_SA(b, h) + aoff + m * 2048 + k * 1024); } while (0)
#define PG8_LDB(dst, b, h) do { _Pragma("unroll") for (int n = 0; n < 2; ++n) _Pragma("unroll") for (int k = 0; k < 2; ++k) dst[n][k] = *(const PG8_LAS bf16x8*)(lds + PG8_SB(b, h) + boff + n * 2048 + k * 1024); } while (0)
#define PG8_MMA(ai, bj, At, Bt) do { __builtin_amdgcn_s_setprio(1); _Pragma("unroll") for (int m = 0; m < 4; ++m) _Pragma("unroll") for (int n = 0; n < 2; ++n) _Pragma("unroll") for (int k = 0; k < 2; ++k) \
        acc[ai][bj][m][n] = __builtin_amdgcn_mfma_f32_16x16x32_bf16(Bt[n][k], At[m][k], acc[ai][bj][m][n], 0, 0, 0); __builtin_amdgcn_s_setprio(0); } while (0)
#define PG8_WAIT_V(n) asm volatile("s_waitcnt vmcnt(" #n ")" ::: "memory")
#define PG8_WAIT_L(n) asm volatile("s_waitcnt lgkmcnt(" #n ")" ::: "memory")
#define PG8_BAR __builtin_amdgcn_s_barrier()
#define PG8_SCHED __builtin_amdgcn_sched_barrier(0)
    Unit cur, nxt; int ui = 0;
    if (!S.next(0, cur)) return;
    f32x4 acc[2][2][4][2];
#pragma unroll
    for (int a = 0; a < 2; ++a)
#pragma unroll
        for (int b = 0; b < 2; ++b)
#pragma unroll
            for (int m = 0; m < 4; ++m)
#pragma unroll
                for (int n = 0; n < 2; ++n) acc[a][b][m][n] = (f32x4){0.f, 0.f, 0.f, 0.f};
    bf16x8 At[4][2], B0[2][2], B1[2][2];
    const char* cA = (const char*)g.A + (size_t)cur.pm * tstep; const char* cB = (const char*)g.Bt + (size_t)cur.pn * tstep;
    S.a_ready(cur);
    if constexpr (SP2) {
        PG8_STAGE(PG8_SB(0, 0), cB, voffB); PG8_STAGE(PG8_SB(0, 1), cB + hstep, voffB); PG8_STAGE(PG8_SA(0, 0), cA, voffA); PG8_STAGE(PG8_SA(0, 1), cA + hstep, voffA);
        if (wr == 1) PG8_BAR;
        PG8_WAIT_V(2); PG8_BAR;
        PG8_STAGE(PG8_SB(1, 0), cB + kstep, voffB); PG8_STAGE(PG8_SA(1, 0), cA + kstep, voffA); PG8_STAGE(PG8_SB(1, 1), cB + hstep + kstep, voffB);
        PG8_WAIT_V(6); PG8_BAR;
    } else {
        PG8_STAGE(PG8_SB(0, 0), cB, voffB); PG8_STAGE(PG8_SA(0, 0), cA, voffA); PG8_STAGE(PG8_SB(0, 1), cB + hstep, voffB); PG8_STAGE(PG8_SA(0, 1), cA + hstep, voffA);
        if (wr == 1) PG8_BAR;
        PG8_WAIT_V(4); PG8_BAR;
        PG8_STAGE(PG8_SB(1, 0), cB + kstep, voffB); PG8_STAGE(PG8_SA(1, 0), cA + kstep, voffA); PG8_STAGE(PG8_SB(1, 1), cB + hstep + kstep, voffB);
        PG8_WAIT_V(6); PG8_BAR;
    }
    for (;;) {
        const bool has_next = S.next(ui + 1, nxt);
        const char* nA = has_next ? (const char*)g.A + (size_t)nxt.pm * tstep : cA; const char* nB = has_next ? (const char*)g.Bt + (size_t)nxt.pn * tstep : cB;
        for (int t = 0; t < nt; t += 2) {
            const bool last = (t == nt - 2);
            const char* a1 = cA + (size_t)(t + 1) * kstep;
            const char* a2 = last ? nA : cA + (size_t)(t + 2) * kstep; const char* b2 = last ? nB : cB + (size_t)(t + 2) * kstep;
            const char* a3 = a2 + kstep; const char* b3 = b2 + kstep;
            if (last && has_next) S.a_ready(nxt);
            if constexpr (SP2) {
            PG8_LDB(B0, 0, 0); PG8_LDB(B1, 0, 1); PG8_SCHED; PG8_LDA(At, 0, 0); PG8_STAGE(PG8_SA(1, 1), a1 + hstep, voffA);
            PG8_WAIT_V(8); PG8_WAIT_L(0); PG8_BAR; PG8_MMA(0, 0, At, B0); PG8_MMA(0, 1, At, B1); PG8_BAR; PG8_SCHED;
            PG8_LDA(At, 0, 1); PG8_STAGE(PG8_SB(0, 0), b2, voffB); PG8_STAGE(PG8_SB(0, 1), b2 + hstep, voffB); PG8_STAGE(PG8_SA(0, 0), a2, voffA);
            PG8_WAIT_V(8); PG8_WAIT_L(0); PG8_BAR; PG8_MMA(1, 0, At, B0); PG8_MMA(1, 1, At, B1); PG8_BAR; PG8_SCHED;
            PG8_LDB(B0, 1, 0); PG8_LDB(B1, 1, 1); PG8_SCHED; PG8_LDA(At, 1, 0); PG8_STAGE(PG8_SA(0, 1), a2 + hstep, voffA);
            PG8_WAIT_V(8); PG8_WAIT_L(0); PG8_BAR; PG8_MMA(0, 0, At, B0); PG8_MMA(0, 1, At, B1); PG8_BAR; PG8_SCHED;
            PG8_LDA(At, 1, 1); PG8_STAGE(PG8_SB(1, 0), b3, voffB); PG8_STAGE(PG8_SB(1, 1), b3 + hstep, voffB); PG8_STAGE(PG8_SA(1, 0), a3, voffA);
            PG8_WAIT_V(8); PG8_WAIT_L(0); PG8_BAR; PG8_MMA(1, 0, At, B0); PG8_MMA(1, 1, At, B1); PG8_BAR; PG8_SCHED;
            } else {
            PG8_LDB(B0, 0, 0); PG8_SCHED; PG8_LDA(At, 0, 0); PG8_STAGE(PG8_SA(1, 1), a1 + hstep, voffA);
            PG8_WAIT_L(8); PG8_BAR; PG8_WAIT_L(0); PG8_MMA(0, 0, At, B0); PG8_BAR; PG8_SCHED;
            PG8_LDB(B1, 0, 1); PG8_STAGE(PG8_SB(0, 0), b2, voffB);
            PG8_BAR; PG8_WAIT_L(0); PG8_MMA(0, 1, At, B1); PG8_BAR;
            PG8_LDA(At, 0, 1); PG8_STAGE(PG8_SA(0, 0), a2, voffA);
            PG8_BAR; PG8_WAIT_L(0); PG8_MMA(1, 0, At, B0); PG8_BAR; PG8_SCHED;
            PG8_STAGE(PG8_SB(0, 1), b2 + hstep, voffB);
            PG8_WAIT_V(6); PG8_BAR; PG8_MMA(1, 1, At, B1); PG8_BAR;
            PG8_LDB(B0, 1, 0); PG8_SCHED; PG8_LDA(At, 1, 0); PG8_STAGE(PG8_SA(0, 1), a2 + hstep, voffA);
            PG8_WAIT_L(8); PG8_BAR; PG8_WAIT_L(0); PG8_MMA(0, 0, At, B0); PG8_BAR; PG8_SCHED;
            PG8_LDB(B1, 1, 1); PG8_STAGE(PG8_SB(1, 0), b3, voffB);
            PG8_BAR; PG8_WAIT_L(0); PG8_MMA(0, 1, At, B1); PG8_BAR;
            PG8_LDA(At, 1, 1); PG8_STAGE(PG8_SA(1, 0), a3, voffA);
            PG8_BAR; PG8_WAIT_L(0); PG8_MMA(1, 0, At, B0); PG8_BAR; PG8_SCHED;
            PG8_STAGE(PG8_SB(1, 1), b3 + hstep, voffB);
            PG8_WAIT_V(6); PG8_BAR; PG8_MMA(1, 1, At, B1); PG8_BAR;
            }
        }
        if constexpr (ALIGN_EPI) { if (wr == 0) PG8_BAR; }
        if constexpr (!Epi::AFTER_DRAIN) { E(acc, cur, wr, wc, fr, fq); S.done(cur); }
        if (!has_next) break;
#pragma unroll
        for (int a = 0; a < 2; ++a)
#pragma unroll
            for (int b = 0; b < 2; ++b)
#pragma unroll
                for (int m = 0; m < 4; ++m)
#pragma unroll
                    for (int n = 0; n < 2; ++n) acc[a][b][m][n] = (f32x4){0.f, 0.f, 0.f, 0.f};
        cur = nxt; cA = nA; cB = nB; ++ui;
        if constexpr (ALIGN_EPI) { if (wr == 1) PG8_BAR; }
    }
    PG8_WAIT_V(0);
    if constexpr (!ALIGN_EPI) { if (wr == 0) PG8_BAR; }
    PG8_BAR;
    if constexpr (Epi::AFTER_DRAIN) { E.fused(acc, cur, wr, wc, fr, fq, lds, wid, lane); S.done(cur); }
#undef PG8_SA
#undef PG8_SB
#undef PG8_STAGE
#undef PG8_LDA
#undef PG8_LDB
#undef PG8_MMA
#undef PG8_WAIT_V
#undef PG8_WAIT_L
#undef PG8_BAR
#undef PG8_SCHED
}
}

constexpr int DM = 1024, NPROMPT = 4 * 4096, NSAMPLE = 32 * 2048, MROWS = NPROMPT + NSAMPLE;
constexpr int QKVW = 3072, DFF = 2816, GUW = 2 * DFF;
constexpr float LOG2E = 1.4426950408889634f, RMS_EPS = 1e-6f;
constexpr size_t MiB = 1u << 20;
constexpr size_t WS_WIN = 2 * MiB, WS_WO = 8 * MiB, WS_WGU = 10 * MiB, WS_WD = 22 * MiB, WS_SS = 28 * MiB;
constexpr size_t WS_XN = 34 * MiB;
constexpr size_t WS_MIX = 194 * MiB;
constexpr size_t WS_QKV = 354 * MiB;
constexpr size_t WS_END = 834 * MiB;
constexpr int RING_BYTES = 131072, LDS_BYTES = 147456;

#define LAS __attribute__((address_space(3)))
typedef unsigned short bf16_t;
typedef short bf16x8 __attribute__((ext_vector_type(8)));
typedef short v4i16 __attribute__((ext_vector_type(4)));
typedef float f32x4 __attribute__((ext_vector_type(4)));
typedef unsigned u32x4 __attribute__((ext_vector_type(4)));
typedef unsigned u32x2 __attribute__((ext_vector_type(2)));

typedef float f32x2_t __attribute__((ext_vector_type(2))); typedef __bf16 bf16x2_t __attribute__((ext_vector_type(2)));
__device__ __forceinline__ unsigned cvtpk(float lo, float hi) { const f32x2_t v = {lo, hi}; const bf16x2_t b = __builtin_convertvector(v, bf16x2_t); return __builtin_bit_cast(unsigned, b); }
__device__ __forceinline__ float wave_sum(float v) {
#pragma unroll
    for (int o = 1; o < 64; o <<= 1) v += __shfl_xor(v, o);
    return v;
}

namespace att {
constexpr int VRS = 160, VBUF = 32 * VRS, KRS = 144, KBUF = 32 * KRS, WBUF = VBUF + KBUF;
constexpr int LDS_TAB = 8 * WBUF + 256, LDS_EXCH = 98304, LDS_GAIN = 106496;
constexpr float RESCALE_THR = 6.0f;
constexpr float M_INIT = -4096.f;
typedef float f32x2 __attribute__((ext_vector_type(2)));
struct Tile { f32x4 o[4]; float la; float m; };
__device__ __forceinline__ f32x4 mfma16(bf16x8 a, bf16x8 b, f32x4 c) { return __builtin_amdgcn_mfma_f32_16x16x32_bf16(a, b, c, 0, 0, 0); }
__device__ __forceinline__ v4i16 trd(LAS const unsigned char* p) { return __builtin_amdgcn_ds_read_tr16_b64_v4i16((LAS v4i16*)p); }
__device__ __forceinline__ void tile_init(Tile& t) {
#pragma unroll
    for (int dt = 0; dt < 4; ++dt) t.o[dt] = (f32x4){0.f, 0.f, 0.f, 0.f};
    t.la = 0.f; t.m = M_INIT;
}
__device__ __forceinline__ bf16x8 tile_softmax(Tile& t, float (&x)[8]) {
    float mx = fmaxf(fmaxf(fmaxf(x[0], x[1]), fmaxf(x[2], x[3])), fmaxf(fmaxf(x[4], x[5]), fmaxf(x[6], x[7])));
    { const auto r16 = __builtin_amdgcn_permlane16_swap(__float_as_uint(mx), __float_as_uint(mx), false, false); mx = fmaxf(__uint_as_float(r16[0]), __uint_as_float(r16[1])); }
    { const auto r32 = __builtin_amdgcn_permlane32_swap(__float_as_uint(mx), __float_as_uint(mx), false, false); mx = fmaxf(__uint_as_float(r32[0]), __uint_as_float(r32[1])); }
    if (__any(mx > RESCALE_THR)) {
        const float d = fmaxf(mx, 0.f), alpha = __builtin_amdgcn_exp2f(-d); t.m += d;
#pragma unroll
        for (int i = 0; i < 8; ++i) x[i] -= d;
#pragma unroll
        for (int dt = 0; dt < 4; ++dt) t.o[dt] = t.o[dt] * alpha;
        t.la = t.la * alpha;
    }
    float p[8];
#pragma unroll
    for (int i = 0; i < 8; ++i) p[i] = __builtin_amdgcn_exp2f(x[i]);
    t.la += ((p[0] + p[1]) + (p[2] + p[3])) + ((p[4] + p[5]) + (p[6] + p[7]));
    u32x4 pw; pw.x = cvtpk(p[0], p[1]); pw.y = cvtpk(p[2], p[3]); pw.z = cvtpk(p[4], p[5]); pw.w = cvtpk(p[6], p[7]);
    return __builtin_bit_cast(bf16x8, pw);
}
__device__ __forceinline__ void tile_pv(Tile& t, const bf16x8 pf, const bf16x8 (&vf)[4]) {
#pragma unroll
    for (int dt = 0; dt < 4; ++dt) t.o[dt] = mfma16(vf[dt], pf, t.o[dt]);
}
__device__ __forceinline__ void read_vfrags(bf16x8 (&vf)[4], LAS const unsigned char* vp) {
#pragma unroll
    for (int dt = 0; dt < 4; ++dt) { const v4i16 lo = trd(vp + dt * 32), hi = trd(vp + 16 * VRS + dt * 32);
        vf[dt] = (bf16x8){lo[0], lo[1], lo[2], lo[3], hi[0], hi[1], hi[2], hi[3]}; }
}
template <int SH, int NT, int QS, int CS, int NP> __device__ __forceinline__ void dil_run(Tile (&tl)[NT], const bf16x8 (&qf)[NT][2], const bf16_t* qkv_seq, int h, int T, int qb, float sld, LAS unsigned char* vbuf, int lane) {
    constexpr int D = 1 << SH;
    const int n = lane & 15, g = lane >> 4;
    const int lo_t = 64 - (qb >> SH), hi_t = 64 + ((T - 1 - qb) >> SH);
    float relb[NT], rlo[NT], rhi[NT];
#pragma unroll
    for (int c = 0; c < NT; ++c) { const int off = 64 + CS * c + QS * n; relb[c] = (float)(4 * g - off); rlo[c] = (float)max(-64, lo_t - off); rhi[c] = (float)min(64, hi_t - off); }
    const char* kvbase = (const char*)(qkv_seq + 2048 + h * 64 + (lane & 7) * 8);
    const int vrow = lane >> 3;
    LAS unsigned char* vw = vbuf + vrow * VRS + (lane & 7) * 16;
    LAS unsigned char* kw = vbuf + VBUF + vrow * KRS + (lane & 7) * 16;
    LAS const unsigned char* vp = vbuf + (4 * g + (n >> 2)) * VRS + (n & 3) * 8;
    LAS const unsigned char* kr = vbuf + VBUF + n * KRS + g * 16;
    u32x4 kA[4], vA[4];
#define DIL_LOAD(p, KN, VN) do { \
    _Pragma("unroll") for (int i = 0; i < 4; ++i) { const int tok = min(max(qb + D * (32 * (p) + vrow + 8 * i - 64), 0), T - 1); \
        const char* rp = kvbase + (unsigned)tok * (unsigned)(QKVW * 2); KN[i] = *(const u32x4*)rp; VN[i] = *(const u32x4*)(rp + 1024); } } while (0)
#define DIL_STEP(p, KN, VN) do { \
        _Pragma("unroll") for (int i = 0; i < 4; ++i) *(LAS u32x4*)(kw + 8 * i * KRS) = KN[i]; \
        bf16x8 kf[2][2]; \
        _Pragma("unroll") for (int tt = 0; tt < 2; ++tt) { kf[tt][0] = *(LAS const bf16x8*)(kr + tt * 16 * KRS); kf[tt][1] = *(LAS const bf16x8*)(kr + tt * 16 * KRS + 64); } \
        _Pragma("unroll") for (int i = 0; i < 4; ++i) *(LAS u32x4*)(vw + 8 * i * VRS) = VN[i]; \
        if ((p) + 1 <= p_hi) DIL_LOAD((p) + 1, KN, VN); \
        bf16x8 pf[NT]; bool act[NT]; \
        _Pragma("unroll") for (int c = 0; c < NT; ++c) { \
              \
            act[c] = (CS < 16) || (32 * (p) + 31 >= CS * c && 32 * (p) <= CS * c + 15 * QS + 128); pf[c] = (bf16x8){0, 0, 0, 0, 0, 0, 0, 0}; \
            if (act[c]) { const float nm = -tl[c].m; const f32x4 negm = (f32x4){nm, nm, nm, nm}; f32x4 s[2]; \
            _Pragma("unroll") for (int tt = 0; tt < 2; ++tt) { s[tt] = mfma16(kf[tt][0], qf[c][0], negm); s[tt] = mfma16(kf[tt][1], qf[c][1], s[tt]); } \
            const float relp = relb[c] + (float)(32 * (p)); float x[8]; \
            _Pragma("unroll") for (int tt = 0; tt < 2; ++tt) \
            _Pragma("unroll") for (int r = 0; r < 4; ++r) { const float rel = relp + (float)(16 * tt + r); const float xv = fmaf(fabsf(rel), sld, s[tt][r]); \
                    x[4 * tt + r] = (__builtin_amdgcn_fmed3f(rel, rlo[c], rhi[c]) == rel) ? xv : -INFINITY; } \
            pf[c] = tile_softmax(tl[c], x); } } \
        bf16x8 vf[4]; read_vfrags(vf, vp); \
        _Pragma("unroll") for (int c = 0; c < NT; ++c) if (act[c]) tile_pv(tl[c], pf[c], vf); } while (0)
    const int p_lo = max(0, lo_t >> 5), p_hi = min(NP - 1, hi_t >> 5);
    DIL_LOAD(p_lo, kA, vA);
#pragma unroll 1
    for (int p = p_lo; p <= p_hi; ++p) DIL_STEP(p, kA, vA);
#undef DIL_STEP
#undef DIL_LOAD
}

__device__ __forceinline__ void na_quad(Tile (&tl)[4], const bf16x8 (&qf)[4][2], const bf16_t* qkv_seq, int h, int r, int rows, int nb, LAS const unsigned char* rpbh, LAS unsigned char* vbuf, int lane) {
    const int n = lane & 15, g = lane >> 4;
    const int qcol = 16 * nb + n, kstart = min(max(16 * nb - 8, 0), 32), wstart = min(max(qcol - 8, 0), 48), wofs = wstart - kstart, cb = kstart - qcol + 15 + 4 * g;
    const int rs0 = min(max(r - 4, 0), rows - 8);
    int boff[8];
#pragma unroll
    for (int tt = 0; tt < 2; ++tt)
#pragma unroll
        for (int q = 0; q < 4; ++q) { const int kc = 16 * tt + 4 * g + q; boff[4 * tt + q] = ((unsigned)(kc - wofs) < 16u) ? 4 * (cb + 16 * tt + q) : 4 * 31; }
    const char* kvbase = (const char*)(qkv_seq + 512 + h * 64 + (lane & 7) * 8);
    const int vrow = lane >> 3;
    LAS unsigned char* vw = vbuf + vrow * VRS + (lane & 7) * 16;
    LAS unsigned char* kw = vbuf + VBUF + vrow * KRS + (lane & 7) * 16;
    LAS const unsigned char* vp = vbuf + (4 * g + (n >> 2)) * VRS + (n & 3) * 8;
    LAS const unsigned char* kfr = vbuf + VBUF + n * KRS + g * 16;
    u32x4 kA[4], vA[4];
#define NA_LOAD(kr, KN, VN) do { const int tb = min(rs0 + (kr), rows - 1) * 64 + kstart + vrow; \
    _Pragma("unroll") for (int i = 0; i < 4; ++i) { const char* rp = kvbase + (unsigned)(tb + 8 * i) * (unsigned)(QKVW * 2); KN[i] = *(const u32x4*)rp; VN[i] = *(const u32x4*)(rp + 1024); } } while (0)
#define NA_STEP(kr, KN, VN) do { \
        _Pragma("unroll") for (int i = 0; i < 4; ++i) *(LAS u32x4*)(kw + 8 * i * KRS) = KN[i]; \
        bf16x8 kf[2][2]; \
        _Pragma("unroll") for (int tt = 0; tt < 2; ++tt) { kf[tt][0] = *(LAS const bf16x8*)(kfr + tt * 16 * KRS); kf[tt][1] = *(LAS const bf16x8*)(kfr + tt * 16 * KRS + 64); } \
        _Pragma("unroll") for (int i = 0; i < 4; ++i) *(LAS u32x4*)(vw + 8 * i * VRS) = VN[i]; \
        if ((kr) + 1 < 11) NA_LOAD((kr) + 1, KN, VN); \
        bf16x8 pf[4]; bool act[4]; \
        _Pragma("unroll") for (int c = 0; c < 4; ++c) { const int rsc = min(max(r + c - 4, 0), rows - 8), kk = rs0 + (kr) - rsc; act[c] = (unsigned)kk < 8u; pf[c] = (bf16x8){0, 0, 0, 0, 0, 0, 0, 0}; \
            if (act[c]) {                             \
            const float nm = -tl[c].m; const f32x4 negm = (f32x4){nm, nm, nm, nm}; f32x4 s[2]; \
            _Pragma("unroll") for (int tt = 0; tt < 2; ++tt) { s[tt] = mfma16(kf[tt][0], qf[c][0], negm); s[tt] = mfma16(kf[tt][1], qf[c][1], s[tt]); } \
            LAS const unsigned char* bt = rpbh + (rs0 + (kr) - (r + c) + 7) * 128; float x[8]; \
            _Pragma("unroll") for (int i = 0; i < 8; ++i) x[i] = s[i >> 2][i & 3] + *(LAS const float*)(bt + boff[i]); \
            pf[c] = tile_softmax(tl[c], x); } } \
        bf16x8 vf[4]; read_vfrags(vf, vp); \
        _Pragma("unroll") for (int c = 0; c < 4; ++c) if (act[c]) tile_pv(tl[c], pf[c], vf); } while (0)
    NA_LOAD(0, kA, vA);
#pragma unroll 1
    for (int kr = 0; kr < 11; ++kr) NA_STEP(kr, kA, vA);
#undef NA_STEP
#undef NA_LOAD
}

__device__ __forceinline__ void regroup(Tile (&tl)[4], LAS unsigned char* buf, int lane) {
    const int n = lane & 15, g = lane >> 4;
    const int qs0 = (n >> 2) * 16 + 4 * (n & 3);
#pragma unroll
    for (int hf = 0; hf < 2; ++hf) {
#pragma unroll
        for (int c = 0; c < 4; ++c)
#pragma unroll
            for (int d2 = 0; d2 < 2; ++d2) *(LAS f32x4*)(buf + (qs0 + c) * 128 + (d2 * 16 + 4 * g) * 4) = tl[c].o[2 * hf + d2];
        if (hf == 0) {
#pragma unroll
            for (int c = 0; c < 4; ++c) { *(LAS float*)(buf + 8192 + ((qs0 + c) * 4 + g) * 4) = tl[c].la; *(LAS float*)(buf + 9216 + (qs0 + c) * 4) = tl[c].m; }
        }
#pragma unroll
        for (int c = 0; c < 4; ++c)
#pragma unroll
            for (int d2 = 0; d2 < 2; ++d2) tl[c].o[2 * hf + d2] = *(LAS const f32x4*)(buf + (c * 16 + n) * 128 + (d2 * 16 + 4 * g) * 4);
        if (hf == 0) {
#pragma unroll
            for (int c = 0; c < 4; ++c) { tl[c].la = *(LAS const float*)(buf + 8192 + ((c * 16 + n) * 4 + g) * 4); tl[c].m = *(LAS const float*)(buf + 9216 + (c * 16 + n) * 4); }
        }
    }
}

__device__ __forceinline__ void finish_tile(Tile& t, LAS float* exch, int h, LAS const float* gainp  , bf16_t* orow, int lane) {
    const int n = lane & 15, g = lane >> 4;
    float l = t.la; l += __shfl_xor(l, 16); l += __shfl_xor(l, 32);
    const float inv = 1.0f / l; float ss = 0.f;
#pragma unroll
    for (int dt = 0; dt < 4; ++dt) { t.o[dt] = t.o[dt] * inv; const f32x4 v = t.o[dt]; ss += (v[0] * v[0] + v[1] * v[1]) + (v[2] * v[2] + v[3] * v[3]); }
    ss += __shfl_xor(ss, 16); ss += __shfl_xor(ss, 32);
    if (g == 0) exch[h * 16 + n] = ss;
    __syncthreads();
    float tot = 0.f;
#pragma unroll
    for (int hh = 0; hh < 8; ++hh) tot += exch[hh * 16 + n];
    const float rinv = 1.0f / sqrtf(tot * (1.0f / 512.0f) + RMS_EPS);
#pragma unroll
    for (int dt = 0; dt < 4; ++dt) { const f32x4 v = t.o[dt] * *(LAS const f32x4*)(gainp + 16 * dt) * rinv; u32x2 w; w.x = cvtpk(v[0], v[1]); w.y = cvtpk(v[2], v[3]); *(u32x2*)(orow + 16 * dt) = w; }
}
__device__ __forceinline__ void load_q(bf16x8 (&qf)[2], const bf16_t* qp) { qf[0] = *(const bf16x8*)qp; qf[1] = *(const bf16x8*)(qp + 32); }
#define ATT_PATTERN_FENCE() asm volatile("s_waitcnt vmcnt(0)\n\tbuffer_inv sc1\n\ts_waitcnt vmcnt(0)" ::: "memory")

#ifndef REP_DIL
#define REP_DIL 1
#endif
#ifndef REP_NA
#define REP_NA 1
#endif
__device__ __forceinline__ void attn_phase(LAS unsigned char* lds, const bf16_t* qkv, bf16_t* mix, const float* rpb, const float* g_na, const float* g_dil, int vcu, int G, const int wave) {
    int lane_ = __builtin_amdgcn_mbcnt_hi(~0u, __builtin_amdgcn_mbcnt_lo(~0u, 0u)); asm volatile("" : "+v"(lane_)); const int lane = lane_ & 63, h = wave, tid = h * 64 + lane, n = lane & 15, g = lane >> 4;
    LAS float* tab = (LAS float*)(lds + LDS_TAB);
    { LAS float* gl = (LAS float*)(lds + LDS_GAIN); for (int i = tid; i < 1024; i += 512) gl[i] = (i < 512) ? g_dil[i] : g_na[i - 512]; }
    for (int i = tid; i < 8 * 16 * 32; i += 512) { const int c = i & 31, rr = (i >> 5) & 15, hh = i >> 9; tab[i] = (c < 31 && rr < 15) ? rpb[(hh * 15 + rr) * 31 + c] * LOG2E : -INFINITY; }
    __syncthreads();
    LAS unsigned char* vbuf = lds + h * WBUF;
    LAS float* exch = (LAS float*)(lds + LDS_EXCH);
    int par = 0;
    {
        const float sl2 = -LOG2E * __builtin_amdgcn_exp2f(-(float)(h + 1));
        for (int rep = 0; rep < REP_DIL; ++rep)
        for (int item = vcu; item < 1280; item += G) {
            const int jr = item / G, u0r = (item - jr * G) >> 2; const int unit = (G == 256) ? jr * 64 + (u0r & ~7) + ((u0r + jr) & 7) : (item >> 2); const int pg = item & 3;
            int sb, T, u0;
            if (unit < 64) { sb = (unit >> 4) * 4096; T = 4096; u0 = (unit & 15) * 256; } else { const int uu = unit - 64; sb = NPROMPT + (uu >> 3) * 2048; T = 2048; u0 = (uu & 7) * 256; }
            const bf16_t* qkv_seq = qkv + (size_t)sb * QKVW;
            const bf16_t* qcolp = qkv_seq + 1536 + h * 64 + 8 * g;
            {
                const int ub = u0 + pg; Tile tl[4]; bf16x8 qf[4][2];
#pragma unroll
                for (int c = 0; c < 4; ++c) { tile_init(tl[c]); load_q(qf[c], qcolp + (size_t)(ub + 4 * c + 16 * n) * QKVW); }
#pragma unroll
                for (int c = 0; c < 4; ++c) { Tile t1[1]; bf16x8 q1[1][2]; t1[0] = tl[c]; q1[0][0] = qf[c][0]; q1[0][1] = qf[c][1];
                    dil_run<4, 1, 1, 0, 5>(t1, q1, qkv_seq, h, T, ub + 4 * c, sl2 * 16.0f, vbuf, lane);
                    tl[c] = t1[0]; }
#pragma unroll
                for (int c = 0; c < 4; ++c) load_q(qf[c], qcolp + (size_t)(ub + 64 * c + 4 * n) * QKVW);
                regroup(tl, vbuf, lane);
                dil_run<2, 4, 1, 16, 6>(tl, qf, qkv_seq, h, T, ub, sl2 * 4.0f, vbuf, lane);
                dil_run<0, 4, 4, 64, 12>(tl, qf, qkv_seq, h, T, ub, sl2, vbuf, lane);
#pragma unroll
                for (int c = 0; c < 4; ++c) {
                    int lane2 = lane; asm volatile("" : "+v"(lane2));
                    const int n2 = lane2 & 15, g2 = lane2 >> 4;
                    finish_tile(tl[c], exch + par * 128, h, (LAS const float*)(lds + LDS_GAIN) + h * 64 + 4 * g2, mix + (size_t)(sb + ub + 64 * c + 4 * n2) * DM + 512 + h * 64 + 4 * g2, lane2);
                    par ^= 1; }
            }
        }
    }
    {
        int lane_n = __builtin_amdgcn_mbcnt_hi(~0u, __builtin_amdgcn_mbcnt_lo(~0u, 0u)); asm volatile("" : "+v"(lane_n)); const int lane = lane_n & 63, n = lane & 15, g = lane >> 4;
        LAS const unsigned char* rpbh = (LAS const unsigned char*)(tab + h * (16 * 32));
        for (int rep = 0; rep < REP_NA; ++rep)
        for (int item = vcu; item < 1280; item += G) {
            const int qd = item >> 2, nb = item & 3;
            int sb, rows, r;
            if (qd < 64) { sb = (qd >> 4) * 4096; rows = 64; r = (qd & 15) * 4; } else { const int ii = qd - 64; sb = NPROMPT + (ii >> 3) * 2048; rows = 32; r = (ii & 7) * 4; }
            const bf16_t* qkv_seq = qkv + (size_t)sb * QKVW;
            Tile tl[4]; bf16x8 qf[4][2];
#pragma unroll
            for (int c = 0; c < 4; ++c) { tile_init(tl[c]); load_q(qf[c], qkv_seq + (size_t)((r + c) * 64 + 16 * nb + n) * QKVW + h * 64 + 8 * g); }
            na_quad(tl, qf, qkv_seq, h, r, rows, nb, rpbh, vbuf, lane);
#pragma unroll
            for (int c = 0; c < 4; ++c) { int lane2 = lane; asm volatile("" : "+v"(lane2)); const int n2 = lane2 & 15, g2 = lane2 >> 4;
                finish_tile(tl[c], exch + par * 128, h, (LAS const float*)(lds + LDS_GAIN) + 512 + h * 64 + 4 * g2, mix + (size_t)(sb + (r + c) * 64 + 16 * nb + n2) * DM + h * 64 + 4 * g2, lane2); par ^= 1; }
        }
    }
    __syncthreads();
}
}

__device__ __forceinline__ void transpose_item(const float* W, int K, int N, bf16_t* WT, int k0, int n0, int dst_row0, const float* kgain, float sn, LAS float* scr, int lane) {
#pragma unroll
    for (int i = 0; i < 32; ++i) { const int kk = 2 * i + (lane >> 5); float v = W[(size_t)(k0 + kk) * N + n0 + (lane & 31)] * sn; if (kgain) v *= kgain[k0 + kk]; scr[kk * 33 + (lane & 31)] = v; }
    asm volatile("s_waitcnt lgkmcnt(0)" ::: "memory");
    const int c = lane & 7;
#pragma unroll
    for (int j = 0; j < 4; ++j) { const int nn = (lane >> 3) + 8 * j; const LAS float* s = scr + (8 * c) * 33 + nn;
        u32x4 o; o.x = cvtpk(s[0 * 33], s[1 * 33]); o.y = cvtpk(s[2 * 33], s[3 * 33]); o.z = cvtpk(s[4 * 33], s[5 * 33]); o.w = cvtpk(s[6 * 33], s[7 * 33]);
        *(u32x4*)(WT + (size_t)(dst_row0 + nn) * K + k0 + 8 * c) = o; }
    asm volatile("s_waitcnt lgkmcnt(0)" ::: "memory");
}
template <bool TOBF> __device__ __forceinline__ void rms_row(const float* xrow, const float* gain, void* orow, int lane) {
    const f32x4* xr = (const f32x4*)xrow + lane; const f32x4* gr = (const f32x4*)gain + lane;
    f32x4 v[4]; float s = 0.f;
#pragma unroll
    for (int j = 0; j < 4; ++j) { v[j] = xr[64 * j]; s += (v[j][0] * v[j][0] + v[j][1] * v[j][1]) + (v[j][2] * v[j][2] + v[j][3] * v[j][3]); }
    const float rinv = 1.0f / sqrtf(wave_sum(s) * (1.0f / 1024.0f) + RMS_EPS);
#pragma unroll
    for (int j = 0; j < 4; ++j) { const f32x4 o = v[j] * rinv * gr[64 * j];
        if (TOBF) { u32x2 w; w.x = cvtpk(o[0], o[1]); w.y = cvtpk(o[2], o[3]); ((u32x2*)orow)[64 * j + lane] = w; }
        else ((f32x4*)orow)[64 * j + lane] = o; }
}

template <bool TOBF> __device__ __forceinline__ void rms_rows(const float* p0, const float* p1, const float* gain, void* obase, int gw, int NGW, int lane) {
    f32x4 gr[4], a[4], b[4], c[4];
#pragma unroll
    for (int j = 0; j < 4; ++j) gr[j] = ((const f32x4*)gain)[64 * j + lane];
#define RR_LOAD(dst, mm) do { const int m_ = min((mm), MROWS - 1); const f32x4* xr_ = (const f32x4*)(m_ < NPROMPT ? p0 + (size_t)m_ * DM : p1 + (size_t)(m_ - NPROMPT) * DM) + lane; \
    _Pragma("unroll") for (int j = 0; j < 4; ++j) dst[j] = xr_[64 * j]; } while (0)
    RR_LOAD(a, gw); RR_LOAD(b, gw + NGW);
    for (int m = gw; m < MROWS; m += NGW) {
        RR_LOAD(c, m + 2 * NGW);
        float s = 0.f;
#pragma unroll
        for (int j = 0; j < 4; ++j) s += (a[j][0] * a[j][0] + a[j][1] * a[j][1]) + (a[j][2] * a[j][2] + a[j][3] * a[j][3]);
        const float rinv = 1.0f / sqrtf(wave_sum(s) * (1.0f / 1024.0f) + RMS_EPS);
#pragma unroll
        for (int j = 0; j < 4; ++j) { const f32x4 o = a[j] * rinv * gr[j];
            if (TOBF) { u32x2 w; w.x = cvtpk(o[0], o[1]); w.y = cvtpk(o[2], o[3]); ((u32x2*)obase)[(size_t)m * 256 + 64 * j + lane] = w; }
            else ((f32x4*)obase)[(size_t)m * 256 + 64 * j + lane] = o; }
#pragma unroll
        for (int j = 0; j < 4; ++j) { a[j] = b[j]; b[j] = c[j]; }
    }
#undef RR_LOAD
}

__device__ __forceinline__ void final_rows(const bf16_t* y, const float* ss, const float* gain, float* out, int gw, int NGW, int lane) {
    f32x4 gr[4]; u32x2 a[4], b[4], c[4]; float sa, sb, sc;
#pragma unroll
    for (int j = 0; j < 4; ++j) gr[j] = ((const f32x4*)gain)[64 * j + lane];
#define FR_LOAD(dst, sd, mm) do { const int m_ = min((mm), MROWS - 1); const u32x2* yr_ = (const u32x2*)(y + (size_t)m_ * DM) + lane; \
    _Pragma("unroll") for (int j = 0; j < 4; ++j) dst[j] = yr_[64 * j]; sd = ss[(size_t)m_ * 16 + (lane & 15)]; } while (0)
    FR_LOAD(a, sa, gw); FR_LOAD(b, sb, gw + NGW);
    for (int m = gw; m < MROWS; m += NGW) {
        FR_LOAD(c, sc, m + 2 * NGW);
        float t = sa; t += __shfl_xor(t, 1); t += __shfl_xor(t, 2); t += __shfl_xor(t, 4); t += __shfl_xor(t, 8);
        const float rinv = 1.0f / sqrtf(t * (1.0f / 1024.0f) + RMS_EPS);
#pragma unroll
        for (int j = 0; j < 4; ++j) { const f32x4 v = (f32x4){__uint_as_float(a[j].x << 16), __uint_as_float(a[j].x & 0xffff0000u), __uint_as_float(a[j].y << 16), __uint_as_float(a[j].y & 0xffff0000u)};
            ((f32x4*)out)[(size_t)m * 256 + 64 * j + lane] = v * rinv * gr[j]; }
#pragma unroll
        for (int j = 0; j < 4; ++j) { a[j] = b[j]; b[j] = c[j]; }
        sa = sb; sb = sc;
    }
#undef FR_LOAD
}

#define XB_TMO      128
#define XB_XCNT(j)  (256  + 64 * (j))
#define XB_XSUB(j)  (1280 + 64 * (j))
#define XB_XGEN(j)  (2304 + 64 * (j))
#define XB_TOP      3328
#define XB_TOPGEN   3392
#define XCD_BAR_WORDS 3456
#define XB_SPIN_CAP (1u << 18)

__device__ __forceinline__ unsigned xb_ld(unsigned* p)              { return __hip_atomic_load(p, __ATOMIC_RELAXED, __HIP_MEMORY_SCOPE_AGENT); }
__device__ __forceinline__ unsigned xb_add(unsigned* p, unsigned v) { return __hip_atomic_fetch_add(p, v, __ATOMIC_RELAXED, __HIP_MEMORY_SCOPE_AGENT); }
__device__ __forceinline__ unsigned xb_xcc_id() { return (unsigned)__builtin_amdgcn_s_getreg((3 << 11) | 20) & 0xFu; }
#define XB_SPIN(cond, bar) do { unsigned _sp = 0; while (cond) { __builtin_amdgcn_s_sleep(1); \
    if ((++_sp & 255u) == 0u) { if (xb_ld(&(bar)[XB_TMO])) break; if (_sp > XB_SPIN_CAP) { atomicAdd(&(bar)[XB_TMO], 1u); break; } } } } while (0)

struct XcdBarrier {
    unsigned* bar; unsigned x;
    volatile LAS unsigned* st;
};

__device__ __forceinline__ XcdBarrier xcd_barrier_post(unsigned* bar, volatile LAS unsigned* st) {
    XcdBarrier b; b.bar = bar; b.x = xb_xcc_id(); b.st = st;
    if (threadIdx.x == 0) (void)xb_add(&bar[XB_XCNT(b.x)], 1u);
    return b;
}
__device__ __forceinline__ void xcd_barrier_complete(unsigned* bar, unsigned x, unsigned& nloc, unsigned& nx) {
    const unsigned G = gridDim.x * gridDim.y * gridDim.z;
    unsigned sum, cnt, mine, sp = 0u;
    for (;;) {
        sum = 0u; cnt = 0u; mine = 0u;
#pragma unroll
        for (unsigned j = 0; j < 16; ++j) { const unsigned c = xb_ld(&bar[XB_XCNT(j)]); sum += c; cnt += (c > 0u) ? 1u : 0u; mine = (j == x) ? c : mine; }
        if (sum == G) break;
        __builtin_amdgcn_s_sleep(1);
        if ((++sp & 255u) == 0u) { if (xb_ld(&bar[XB_TMO])) break; if (sp > XB_SPIN_CAP) { atomicAdd(&bar[XB_TMO], 1u); break; } }
    }
    nloc = mine > 0u ? mine : 1u; nx = cnt > 0u ? cnt : 1u;
}

__device__ __forceinline__ void xcd_barrier(const XcdBarrier& b, const int wave) {
    asm volatile("s_waitcnt vmcnt(0)" ::: "memory");
    __syncthreads();
    if (wave == 0 && __builtin_amdgcn_mbcnt_hi(~0u, __builtin_amdgcn_mbcnt_lo(~0u, 0u)) == 0u) {
        unsigned* bar = b.bar;
        __builtin_amdgcn_s_waitcnt(0);
        unsigned nloc = b.st[0], nx = b.st[1];
        if (nloc == 0u) { xcd_barrier_complete(bar, b.x, nloc, nx); b.st[0] = nloc; b.st[1] = nx; }
        const unsigned old = xb_add(&bar[XB_XSUB(b.x)], 1u);
        const unsigned gen = old / nloc;
        if (old + 1u == (gen + 1u) * nloc) {
            __builtin_amdgcn_fence(__ATOMIC_RELEASE, "agent");
            asm volatile("s_waitcnt vmcnt(0)" ::: "memory");
            const unsigned og = xb_add(&bar[XB_TOP], 1u);
            const unsigned tg = og / nx;
            if (og + 1u == (tg + 1u) * nx) xb_add(&bar[XB_TOPGEN], 1u);
            else XB_SPIN(xb_ld(&bar[XB_TOPGEN]) == tg, bar);
            __builtin_amdgcn_fence(__ATOMIC_ACQUIRE, "agent");
            xb_add(&bar[XB_XGEN(b.x)], 1u);
            asm volatile("s_waitcnt vmcnt(0)" ::: "memory");
        } else {
            XB_SPIN(xb_ld(&bar[XB_XGEN(b.x)]) == gen, bar);
            __builtin_amdgcn_fence(__ATOMIC_ACQUIRE, "agent");
            asm volatile("s_waitcnt vmcnt(0)" ::: "memory");
        }
    }
    __syncthreads();
}

struct Args { const float* in[13]; float* out; unsigned char* ws; };

#define GRID_SYNC() do { asm volatile("s_waitcnt vmcnt(0)" ::: "memory"); grid.sync(); asm volatile("buffer_inv sc1\n\ts_waitcnt vmcnt(0)" ::: "memory"); } while (0)
#define XSYNC() xcd_barrier(xbar, wave)
__global__ void __launch_bounds__(512, 2) hymba_fwd(Args a) {
    extern __shared__ __attribute__((aligned(16))) unsigned char lds_raw[];
    cg::grid_group grid = cg::this_grid();
    LAS unsigned char* lds = (LAS unsigned char*)lds_raw;
    const int wave = __builtin_amdgcn_readfirstlane((int)threadIdx.x >> 6);
    volatile LAS unsigned* xst = (volatile LAS unsigned*)(lds + RING_BYTES + 64);
    if (threadIdx.x < 2) xst[threadIdx.x] = 0u;
    __syncthreads();
    const XcdBarrier xbar = xcd_barrier_post((unsigned*)(a.ws + 4096), xst);
    const int G = gridDim.x, bx = blockIdx.x, vcu = (G % 8 == 0) ? (bx % 8) * (G / 8) + bx / 8 : bx;
    unsigned char* ws = a.ws;
    bf16_t* Win_t = (bf16_t*)(ws + WS_WIN); bf16_t* Wo_t = (bf16_t*)(ws + WS_WO); bf16_t* Wgu_t = (bf16_t*)(ws + WS_WGU); bf16_t* Wd_t = (bf16_t*)(ws + WS_WD);
    float* SS = (float*)(ws + WS_SS); bf16_t* XN = (bf16_t*)(ws + WS_XN); bf16_t* MIX = (bf16_t*)(ws + WS_MIX); bf16_t* QKV = (bf16_t*)(ws + WS_QKV); bf16_t* HB = (bf16_t*)(ws + WS_QKV);
    const float* xp = a.in[0]; const float* xs = a.in[1];
    const int gw = vcu * 8 + wave, NGW = G * 8;

#ifndef REP_P0
#define REP_P0 1
#endif
    for (int rep0 = 0; rep0 < REP_P0; ++rep0) {
        int lane = __builtin_amdgcn_mbcnt_hi(~0u, __builtin_amdgcn_mbcnt_lo(~0u, 0u)); asm volatile("" : "+v"(lane)); lane &= 63;
        LAS float* scr = (LAS float*)(lds + wave * 16384);
        constexpr int I_IN = 16 * 96, I_O = 16 * 32, I_G = 16 * 88, I_D = 44 * 32, NITEMS = I_IN + I_O + 2 * I_G + I_D;
        for (int it = gw; it < NITEMS; it += NGW) {
            int r = it;
            if (r < I_IN) { const int kb = r / 96, nb = r % 96, n0 = 32 * nb; const float sn = (n0 < 512 || (n0 >= 1536 && n0 < 2048)) ? 0.125f * LOG2E : 1.0f;
                transpose_item(a.in[2], 1024, QKVW, Win_t, 64 * kb, n0, n0, nullptr, sn, scr, lane); continue; } r -= I_IN;
            if (r < I_O) { const int kb = r / 32, nb = r % 32; transpose_item(a.in[7], 1024, 1024, Wo_t, 64 * kb, 32 * nb, 32 * nb, nullptr, 1.0f, scr, lane); continue; } r -= I_O;
            if (r < 2 * I_G) { const int up = r >= I_G ? 1 : 0; if (up) r -= I_G; const int kb = r / 88, nb = r % 88, n0 = 32 * nb;
                transpose_item(up ? a.in[10] : a.in[9], 1024, DFF, Wgu_t, 64 * kb, n0, (n0 >> 7) * 256 + (n0 & 127) + up * 128, a.in[8], 1.0f, scr, lane); continue; } r -= 2 * I_G;
            { const int kb = r / 32, nb = r % 32; transpose_item(a.in[11], DFF, 1024, Wd_t, 64 * kb, 32 * nb, 32 * nb, nullptr, 1.0f, scr, lane); }
        }
        rms_rows<true>(xp, xs, a.in[4], XN, gw, NGW, lane);
    }
    GRID_SYNC();
#ifdef REP_SYNC
    for (int rs_ = 0; rs_ < REP_SYNC; ++rs_) GRID_SYNC();
#endif
    {
        pg8::Gemm g{XN, Win_t, MROWS, QKVW, 1024}; pg8::StaticOrder S; S.init(MROWS, QKVW, G, bx);
        pg8::EpiStoreBf16 E{QKV, QKVW};
        pg8::gemm_phase<pg8::EpiStoreBf16, pg8::StaticOrder, true, true>(lds, g, S, E, wave);
#ifdef REP_P1
        pg8::gemm_phase<pg8::EpiStoreBf16, pg8::StaticOrder, true, true>(lds, g, S, E, wave);
#endif
    }
    XSYNC();
    att::attn_phase(lds, QKV, MIX, a.in[3], a.in[5], a.in[6], vcu, G, wave);
    XSYNC();
    {
        pg8::Gemm g{MIX, Wo_t, MROWS, 1024, 1024}; pg8::StaticOrder S; S.init(MROWS, 1024, G, bx);
        pg8::EpiResid<true> E{xp, xs, NPROMPT, nullptr, XN, SS};
        pg8::gemm_phase<pg8::EpiResid<true>, pg8::StaticOrder, true, true>(lds, g, S, E, wave);
#ifdef REP_P3
        pg8::gemm_phase<pg8::EpiResid<true>, pg8::StaticOrder, true, true>(lds, g, S, E, wave);
#endif
    }
    XSYNC();
    {
        pg8::Gemm g{XN, Wgu_t, MROWS, GUW, 1024}; pg8::StaticOrder S; S.init(MROWS, GUW, G, bx);
        pg8::EpiSwiglu E{HB, DFF, SS, (LAS float*)(lds + RING_BYTES + 1024), -1};
        pg8::gemm_phase<pg8::EpiSwiglu, pg8::StaticOrder, true, true>(lds, g, S, E, wave);
#ifdef REP_P4
        pg8::gemm_phase<pg8::EpiSwiglu, pg8::StaticOrder, true, true>(lds, g, S, E, wave);
#endif
    }
    XSYNC();
    {
        pg8::Gemm g{HB, Wd_t, MROWS, 1024, DFF}; pg8::StaticOrder S; S.init(MROWS, 1024, G, bx);
        pg8::EpiResid<false> E{nullptr, nullptr, 0, XN, MIX, SS};
        pg8::gemm_phase<pg8::EpiResid<false>, pg8::StaticOrder, true, true>(lds, g, S, E, wave);
    }
    XSYNC();
    { int l6 = __builtin_amdgcn_mbcnt_hi(~0u, __builtin_amdgcn_mbcnt_lo(~0u, 0u)); asm volatile("" : "+v"(l6)); l6 &= 63;
      final_rows(MIX, SS, a.in[12], a.out, gw, NGW, l6); }
}

extern "C" void kernel_launch(void* const* d_in, const int* in_sizes, int n_in, void* d_out, int out_size, void* d_ws, size_t ws_size, hipStream_t stream) {
    static int grid = 0;
    if (grid == 0) {
        if (n_in != 13 || out_size != MROWS * DM || ws_size < WS_END) { fprintf(stderr, "kernel_launch: unexpected shapes (n_in %d out %d ws %zu)\n", n_in, out_size, ws_size); grid = -1; return; }
        int dev = 0, cus = 0, per_cu = 0;
        hipGetDevice(&dev); hipDeviceGetAttribute(&cus, hipDeviceAttributeMultiprocessorCount, dev);
        if (hipFuncSetAttribute((const void*)hymba_fwd, hipFuncAttributeMaxDynamicSharedMemorySize, LDS_BYTES) != hipSuccess) { fprintf(stderr, "kernel_launch: hipFuncSetAttribute failed\n"); }
        if (hipOccupancyMaxActiveBlocksPerMultiprocessor(&per_cu, (const void*)hymba_fwd, 512, LDS_BYTES) != hipSuccess || per_cu < 1) { fprintf(stderr, "kernel_launch: occupancy query says %d\n", per_cu); per_cu = 1; }
        (void)hipGetLastError();
        grid = cus * per_cu;
    }
    if (grid < 0) return;
    if (hipMemsetAsync(d_ws, 0, 32768, stream) != hipSuccess) { fprintf(stderr, "kernel_launch: memset of the barrier words failed\n"); return; }
    Args a{};
    for (int i = 0; i < 13; ++i) a.in[i] = (const float*)d_in[i];
    a.out = (float*)d_out; a.ws = (unsigned char*)d_ws;
    void* args[] = {&a};
    hipError_t e = hipLaunchCooperativeKernel((const void*)hymba_fwd, dim3(grid), dim3(512), args, LDS_BYTES, stream);
    if (e != hipSuccess) fprintf(stderr, "cooperative launch failed: %s (grid %d)\n", hipGetErrorString(e), grid);
}
```

```cpp
#include <hip/hip_runtime.h>
#include <hip/hip_cooperative_groups.h>
#include <cstdio>
#include <cstdint>
namespace cg = cooperative_groups;
namespace pg8 {
#define PG8_LAS __attribute__((address_space(3)))
typedef unsigned short bf16_t;
typedef short bf16x8 __attribute__((ext_vector_type(8)));
typedef float f32x4 __attribute__((ext_vector_type(4)));
typedef unsigned u32x4 __attribute__((ext_vector_type(4)));
constexpr int BM = 256, BK = 64, HALF = 128, HTB = HALF * BK * 2  , STAGE_BYTES = 8 * HTB, NXCD = 8, WGM = 8;

__host__ __device__ __forceinline__ int lds_byte(int r, int c) { const int st = (r >> 4) * 2 + (c >> 5), rr = r & 15, cc = c & 31, ob = rr * 64 + cc * 2; return st * 1024 + (ob ^ (((ob >> 9) & 1) << 5)); }
__host__ __device__ __forceinline__ void stage_rc(int b, int& R, int& C) { const int st = b / 1024, sb = b % 1024, swz = sb ^ (((sb >> 9) & 1) << 5); R = (st >> 1) * 16 + swz / 64; C = (st & 1) * 32 + (swz % 64) / 2; }
__host__ __device__ __forceinline__ int perm32(int rho) { const int n = rho >> 4, i = rho & 15; return 8 * (i >> 2) + 4 * n + (i & 3); }

struct Unit { int pm, pn; };
struct Gemm { const bf16_t* A; const bf16_t* Bt; int M, N, K; };

struct StaticOrder {
    int nM, nN, nwg, G, c;
    __host__ __device__ void init(int M, int N, int G_, int c_) { nM = M / BM; nN = N / BM; nwg = nM * nN; G = G_; c = c_; }
    __host__ __device__ bool next(int i, Unit& u) const {
        const long L = (long)i * G + c; if (L >= nwg) return false;
        int wgid = (int)L; { const int q = nwg / NXCD, r = nwg % NXCD, xcd = wgid % NXCD, off = wgid / NXCD; wgid = (xcd < r ? xcd * (q + 1) : r * (q + 1) + (xcd - r) * q) + off; }
        const int nig = WGM * nN, gid = wgid / nig, fm = gid * WGM, gsz = (nM - fm) < WGM ? (nM - fm) : WGM;
        u.pm = fm + ((wgid % nig) % gsz); u.pn = (wgid % nig) / gsz; return true;
    }
    __device__ __forceinline__ void a_ready(const Unit&) const {}
    __device__ __forceinline__ void done(const Unit&) const {}
};


typedef float f32x2_t __attribute__((ext_vector_type(2))); typedef __bf16 bf16x2_t __attribute__((ext_vector_type(2)));
__device__ __forceinline__ unsigned cvt_pk_bf16(float lo, float hi) { const f32x2_t v = {lo, hi}; const bf16x2_t b = __builtin_convertvector(v, bf16x2_t); return __builtin_bit_cast(unsigned, b); }
typedef unsigned u32x2 __attribute__((ext_vector_type(2)));

struct EpiStoreBf16 {
    static constexpr bool PERM = true, AFTER_DRAIN = false;
    bf16_t* O; int ldc;
    __device__ __forceinline__ void operator()(const f32x4 (&acc)[2][2][4][2], const Unit& u, int wr, int wc, int fr, int fq) const {
        const int row0 = u.pm * BM + wr * 64 + fr, col0 = u.pn * BM + wc * 32 + 8 * fq;
#pragma unroll
        for (int ai = 0; ai < 2; ++ai)
#pragma unroll
            for (int m = 0; m < 4; ++m) { bf16_t* rowp = O + (size_t)(row0 + ai * HALF + m * 16) * ldc + col0;
#pragma unroll
                for (int bj = 0; bj < 2; ++bj) { const f32x4 v0 = acc[ai][bj][m][0], v1 = acc[ai][bj][m][1];
                    u32x4 w; w.x = cvt_pk_bf16(v0[0], v0[1]); w.y = cvt_pk_bf16(v0[2], v0[3]); w.z = cvt_pk_bf16(v1[0], v1[1]); w.w = cvt_pk_bf16(v1[2], v1[3]);
                    *(u32x4*)(rowp + bj * HALF) = w; } }
    }
};

template <bool FIRST> struct EpiResid {
    static constexpr bool PERM = false, AFTER_DRAIN = false;
    const float* xp; const float* xs; int split; const bf16_t* rb; bf16_t* ob; float* ss;
    __device__ __forceinline__ void operator()(const f32x4 (&acc)[2][2][4][2], const Unit& u, int wr, int wc, int fr, int fq) const {
        const int row0 = u.pm * BM + wr * 64 + fr, col0 = u.pn * BM + wc * 32 + 4 * fq;
        u32x2 rbv[2][4][2][2];
        if (!FIRST) {
#pragma unroll
            for (int ai = 0; ai < 2; ++ai)
#pragma unroll
                for (int m = 0; m < 4; ++m) { const bf16_t* rbp = rb + (size_t)(row0 + ai * HALF + m * 16) * 1024 + col0;
#pragma unroll
                    for (int bj = 0; bj < 2; ++bj)
#pragma unroll
                        for (int n = 0; n < 2; ++n) rbv[ai][m][bj][n] = *(const u32x2*)(rbp + bj * HALF + n * 16); }
        }
#pragma unroll
        for (int ai = 0; ai < 2; ++ai) {
            f32x4 rx[4][2][2];
            if (FIRST) {
#pragma unroll
                for (int m = 0; m < 4; ++m) { const int row = row0 + ai * HALF + m * 16; const float* rp = (row < split ? xp + (size_t)row * 1024 : xs + (size_t)(row - split) * 1024) + col0;
#pragma unroll
                    for (int bj = 0; bj < 2; ++bj)
#pragma unroll
                        for (int n = 0; n < 2; ++n) rx[m][bj][n] = *(const f32x4*)(rp + bj * HALF + n * 16); }
            }
#pragma unroll
            for (int m = 0; m < 4; ++m) { const int row = row0 + ai * HALF + m * 16;
                bf16_t* op = ob + (size_t)row * 1024 + col0;
                float s = 0.f;
#pragma unroll
                for (int bj = 0; bj < 2; ++bj)
#pragma unroll
                    for (int n = 0; n < 2; ++n) { const int c = bj * HALF + n * 16; f32x4 r;
                        if (FIRST) r = rx[m][bj][n];
                        else { const u32x2 w = rbv[ai][m][bj][n]; r = (f32x4){__uint_as_float(w.x << 16), __uint_as_float(w.x & 0xffff0000u), __uint_as_float(w.y << 16), __uint_as_float(w.y & 0xffff0000u)}; }
                        const f32x4 v = r + acc[ai][bj][m][n];
                        u32x2 w; w.x = cvt_pk_bf16(v[0], v[1]); w.y = cvt_pk_bf16(v[2], v[3]); *(u32x2*)(op + c) = w;
                        s += (v[0] * v[0] + v[1] * v[1]) + (v[2] * v[2] + v[3] * v[3]); }
                s += __shfl_xor(s, 16); s += __shfl_xor(s, 32); if (fq == 0) ss[(size_t)row * 16 + u.pn * 4 + wc] = s; }
        }
    }
};

struct EpiSwiglu {
    static constexpr bool PERM = true, AFTER_DRAIN = false;
    bf16_t* H; int ldh; const float* ss; PG8_LAS float* rtab;
    mutable int pm_c;
    __device__ __forceinline__ void operator()(const f32x4 (&acc)[2][2][4][2], const Unit& u, int wr, int wc, int fr, int fq) const {
        const int row0 = u.pm * BM + wr * 64 + fr, f0 = u.pn * HALF + wc * 32 + 8 * fq;
        PG8_LAS float* rt = rtab + (wr * 4 + wc) * 128;
        if (u.pm != pm_c) {
            pm_c = u.pm;
            const int L = fq * 16 + fr;
#pragma unroll
            for (int k = 0; k < 2; ++k) { const int t = L + 64 * k, row = u.pm * BM + wr * 64 + (t >> 6) * HALF + (t & 63);
                const f32x4* sp = (const f32x4*)(ss + (size_t)row * 16); const f32x4 a = sp[0], b = sp[1], c = sp[2], d = sp[3];
                const float tot = ((a[0] + a[1]) + (a[2] + a[3])) + ((b[0] + b[1]) + (b[2] + b[3])) + ((c[0] + c[1]) + (c[2] + c[3])) + ((d[0] + d[1]) + (d[2] + d[3]));
                rt[t] = 1.0f / sqrtf(tot * (1.0f / 1024.0f) + 1e-6f); }
        }
#pragma unroll
        for (int ai = 0; ai < 2; ++ai)
#pragma unroll
            for (int m = 0; m < 4; ++m) { const int row = row0 + ai * HALF + m * 16;
                const float rinv = rt[ai * 64 + m * 16 + fr];
                float hv[8];
#pragma unroll
                for (int n = 0; n < 2; ++n)
#pragma unroll
                    for (int i = 0; i < 4; ++i) { const float g = acc[ai][0][m][n][i] * rinv, up = acc[ai][1][m][n][i] * rinv;
                        const float e = __builtin_amdgcn_exp2f(g * -1.4426950408889634f); hv[n * 4 + i] = g * __builtin_amdgcn_rcpf(1.0f + e) * up; }
                u32x4 w; w.x = cvt_pk_bf16(hv[0], hv[1]); w.y = cvt_pk_bf16(hv[2], hv[3]); w.z = cvt_pk_bf16(hv[4], hv[5]); w.w = cvt_pk_bf16(hv[6], hv[7]);
                *(u32x4*)(H + (size_t)row * ldh + f0) = w; }
    }
};

template <class Epi, class Sched, bool ALIGN_EPI = false, bool SP2 = false>
__device__ __forceinline__ void gemm_phase(PG8_LAS unsigned char* lds, const Gemm g, const Sched& S, const Epi& E, const int wid_in) {
    int lane_ = __builtin_amdgcn_mbcnt_hi(~0u, __builtin_amdgcn_mbcnt_lo(~0u, 0u)); asm volatile("" : "+v"(lane_)); const int wid = wid_in, lane = lane_ & 63, tid = wid * 64 + lane, wr = wid >> 2, wc = wid & 3, fr = lane & 15, fq = lane >> 4;
    const int K = g.K, nt = K / BK;
    unsigned voffA[2], voffB[2];
#pragma unroll
    for (int i = 0; i < 2; ++i) { int R, C; stage_rc(tid * 16 + i * 8192, R, C); const int Rb = Epi::PERM ? ((R & ~31) + perm32(R & 31)) : R;
        voffA[i] = (unsigned)(R * K + C) * 2u; voffB[i] = (unsigned)(Rb * K + C) * 2u; }
    const size_t kstep = (size_t)(BK * 2);
    const size_t hstep = (size_t)HALF * K * 2;
    const size_t tstep = 2 * hstep;
    const unsigned ldsw = (unsigned)wid * 1024u;
    const int aoff = lds_byte(wr * 64 + fr, fq * 8), boff = lds_byte(wc * 32 + fr, fq * 8);
#define PG8_SA(b, h) (((b) * 2 + (h)) * HTB)
#define PG8_SB(b, h) ((4 + (b) * 2 + (h)) * HTB)
#define PG8_STAGE(bufoff, gbase, voff) do { _Pragma("unroll") for (int _i = 0; _i < 2; ++_i) \
        __builtin_amdgcn_global_load_lds((const unsigned*)((const char*)(gbase) + (voff)[_i]), (PG8_LAS unsigned*)(lds + (bufoff) + ldsw + _i * 8192), 16, 0, 0); } while (0)
#define PG8_LDA(dst, b, h) do { _Pragma("unroll") for (int m = 0; m < 4; ++m) _Pragma("unroll") for (int k = 0; k < 2; ++k) dst[m][k] = *(const PG8_LAS bf16x8*)(lds + PG8_SA(b, h) + aoff + m * 2048 + k * 1024); } while (0)
#define PG8_LDB(dst, b, h) do { _Pragma("unroll") for (int n = 0; n < 2; ++n) _Pragma("unroll") for (int k = 0; k < 2; ++k) dst[n][k] = *(const PG8_LAS bf16x8*)(lds + PG8_SB(b, h) + boff + n * 2048 + k * 1024); } while (0)
#define PG8_MMA(ai, bj, At, Bt) do { __builtin_amdgcn_s_setprio(1); _Pragma("unroll") for (int m = 0; m < 4; ++m) _Pragma("unroll") for (int n = 0; n < 2; ++n) _Pragma("unroll") for (int k = 0; k < 2; ++k) \
        acc[ai][bj][m][n] = __builtin_amdgcn_mfma_f32_16x16x32_bf16(Bt[n][k], At[m][k], acc[ai][bj][m][n], 0, 0, 0); __builtin_amdgcn_s_setprio(0); } while (0)
#define PG8_WAIT_V(n) asm volatile("s_waitcnt vmcnt(" #n ")" ::: "memory")
#define PG8_WAIT_L(n) asm volatile("s_waitcnt lgkmcnt(" #n ")" ::: "memory")
#define PG8_BAR __builtin_amdgcn_s_barrier()
#define PG8_SCHED __builtin_amdgcn_sched_barrier(0)
    Unit cur, nxt; int ui = 0;
    if (!S.next(0, cur)) return;
    f32x4 acc[2][2][4][2];
#pragma unroll
    for (int a = 0; a < 2; ++a)
#pragma unroll
        for (int b = 0; b < 2; ++b)
#pragma unroll
            for (int m = 0; m < 4; ++m)
#pragma unroll
                for (int n = 0; n < 2; ++n) acc[a][b][m][n] = (f32x4){0.f, 0.f, 0.f, 0.f};
    bf16x8 At[4][2], B0[2][2], B1[2][2];
    const char* cA = (const char*)g.A + (size_t)cur.pm * tstep; const char* cB = (const char*)g.Bt + (size_t)cur.pn * tstep;
    S.a_ready(cur);
    if constexpr (SP2) {
        PG8_STAGE(PG8_SB(0, 0), cB, voffB); PG8_STAGE(PG8_SB(0, 1), cB + hstep, voffB); PG8_STAGE(PG8_SA(0, 0), cA, voffA); PG8_STAGE(PG8_SA(0, 1), cA + hstep, voffA);
        if (wr == 1) PG8_BAR;
        PG8_WAIT_V(2); PG8_BAR;
        PG8_STAGE(PG8_SB(1, 0), cB + kstep, voffB); PG8_STAGE(PG8_SA(1, 0), cA + kstep, voffA); PG8_STAGE(PG8_SB(1, 1), cB + hstep + kstep, voffB);
        PG8_WAIT_V(6); PG8_BAR;
    } else {
        PG8_STAGE(PG8_SB(0, 0), cB, voffB); PG8_STAGE(PG8_SA(0, 0), cA, voffA); PG8_STAGE(PG8_SB(0, 1), cB + hstep, voffB); PG8_STAGE(PG8_SA(0, 1), cA + hstep, voffA);
        if (wr == 1) PG8_BAR;
        PG8_WAIT_V(4); PG8_BAR;
        PG8_STAGE(PG8_SB(1, 0), cB + kstep, voffB); PG8_STAGE(PG8_SA(1, 0), cA + kstep, voffA); PG8_STAGE(PG8_SB(1, 1), cB + hstep + kstep, voffB);
        PG8_WAIT_V(6); PG8_BAR;
    }
    for (;;) {
        const bool has_next = S.next(ui + 1, nxt);
        const char* nA = has_next ? (const char*)g.A + (size_t)nxt.pm * tstep : cA; const char* nB = has_next ? (const char*)g.Bt + (size_t)nxt.pn * tstep : cB;
        for (int t = 0; t < nt; t += 2) {
            const bool last = (t == nt - 2);
            const char* a1 = cA + (size_t)(t + 1) * kstep;
            const char* a2 = last ? nA : cA + (size_t)(t + 2) * kstep; const char* b2 = last ? nB : cB + (size_t)(t + 2) * kstep;
            const char* a3 = a2 + kstep; const char* b3 = b2 + kstep;
            if (last && has_next) S.a_ready(nxt);
            if constexpr (SP2) {
            PG8_LDB(B0, 0, 0); PG8_LDB(B1, 0, 1); PG8_SCHED; PG8_LDA(At, 0, 0); PG8_STAGE(PG8_SA(1, 1), a1 + hstep, voffA);
            PG8_WAIT_V(8); PG8_WAIT_L(0); PG8_BAR; PG8_MMA(0, 0, At, B0); PG8_MMA(0, 1, At, B1); PG8_BAR; PG8_SCHED;
            PG8_LDA(At, 0, 1); PG8_STAGE(PG8_SB(0, 0), b2, voffB); PG8_STAGE(PG8_SB(0, 1), b2 + hstep, voffB); PG8_STAGE(PG8_SA(0, 0), a2, voffA);
            PG8_WAIT_V(8); PG8_WAIT_L(0); PG8_BAR; PG8_MMA(1, 0, At, B0); PG8_MMA(1, 1, At, B1); PG8_BAR; PG8_SCHED;
            PG8_LDB(B0, 1, 0); PG8_LDB(B1, 1, 1); PG8_SCHED; PG8_LDA(At, 1, 0); PG8_STAGE(PG8_SA(0, 1), a2 + hstep, voffA);
            PG8_WAIT_V(8); PG8_WAIT_L(0); PG8_BAR; PG8_MMA(0, 0, At, B0); PG8_MMA(0, 1, At, B1); PG8_BAR; PG8_SCHED;
            PG8_LDA(At, 1, 1); PG8_STAGE(PG8_SB(1, 0), b3, voffB); PG8_STAGE(PG8_SB(1, 1), b3 + hstep, voffB); PG8_STAGE(PG8_SA(1, 0), a3, voffA);
            PG8_WAIT_V(8); PG8_WAIT_L(0); PG8_BAR; PG8_MMA(1, 0, At, B0); PG8_MMA(1, 1, At, B1); PG8_BAR; PG8_SCHED;
            } else {
            PG8_LDB(B0, 0, 0); PG8_SCHED; PG8_LDA(At, 0, 0); PG8_STAGE(PG8_SA(1, 1), a1 + hstep, voffA);
            PG8_WAIT_L(8); PG8_BAR; PG8_WAIT_L(0); PG8_MMA(0, 0, At, B0); PG8_BAR; PG8_SCHED;
            PG8_LDB(B1, 0, 1); PG8_STAGE(PG8_SB(0, 0), b2, voffB);
            PG8_BAR; PG8_WAIT_L(0); PG8_MMA(0, 1, At, B1); PG8_BAR;
            PG8_LDA(At, 0, 1); PG8_STAGE(PG8_SA(0, 0), a2, voffA);
            PG8_BAR; PG8_WAIT_L(0); PG8_MMA(1, 0, At, B0); PG8_BAR; PG8_SCHED;
            PG8_STAGE(PG8_SB(0, 1), b2 + hstep, voffB);
            PG8_WAIT_V(6); PG8_BAR; PG8_MMA(1, 1, At, B1); PG8_BAR;
            PG8_LDB(B0, 1, 0); PG8_SCHED; PG8_LDA(At, 1, 0); PG8_STAGE(PG8_SA(0, 1), a2 + hstep, voffA);
            PG8_WAIT_L(8); PG8_BAR; PG8_WAIT_L(0); PG8_MMA(0, 0, At, B0); PG8_BAR; PG8_SCHED;
            PG8_LDB(B1, 1, 1); PG8_STAGE(PG8_SB(1, 0), b3, voffB);
            PG8_BAR; PG8_WAIT_L(0); PG8_MMA(0, 1, At, B1); PG8_BAR;
            PG8_LDA(At, 1, 1); PG8_STAGE(PG8_SA(1, 0), a3, voffA);
            PG8_BAR; PG8_WAIT_L(0); PG8_MMA(1, 0, At, B0); PG8_BAR; PG8_SCHED;
            PG8_STAGE(PG8_SB(1, 1), b3 + hstep, voffB);
            PG8_WAIT_V(6); PG8_BAR; PG8_MMA(1, 1, At, B1); PG8_BAR;
            }
        }
        if constexpr (ALIGN_EPI) { if (wr == 0) PG8_BAR; }
        if constexpr (!Epi::AFTER_DRAIN) { E(acc, cur, wr, wc, fr, fq); S.done(cur); }
        if (!has_next) break;
#pragma unroll
        for (int a = 0; a < 2; ++a)
#pragma unroll
            for (int b = 0; b < 2; ++b)
#pragma unroll
                for (int m = 0; m < 4; ++m)
#pragma unroll
                    for (int n = 0; n < 2; ++n) acc[a][b][m][n] = (f32x4){0.f, 0.f, 0.f, 0.f};
        cur = nxt; cA = nA; cB = nB; ++ui;
        if constexpr (ALIGN_EPI) { if (wr == 1) PG8_BAR; }
    }
    PG8_WAIT_V(0);
    if constexpr (!ALIGN_EPI) { if (wr == 0) PG8_BAR; }
    PG8_BAR;
    if constexpr (Epi::AFTER_DRAIN) { E.fused(acc, cur, wr, wc, fr, fq, lds, wid, lane); S.done(cur); }
#undef PG8_SA
#undef PG8_SB
#undef PG8_STAGE
#undef PG8_LDA
#undef PG8_LDB
#undef PG8_MMA
#undef PG8_WAIT_V
#undef PG8_WAIT_L
#undef PG8_BAR
#undef PG8_SCHED
}
}

constexpr int DM = 1024, NPROMPT = 4 * 4096, NSAMPLE = 32 * 2048, MROWS = NPROMPT + NSAMPLE;
constexpr int QKVW = 3072, DFF = 2816, GUW = 2 * DFF;
constexpr float LOG2E = 1.4426950408889634f, RMS_EPS = 1e-6f;
constexpr size_t MiB = 1u << 20;
constexpr size_t WS_WIN = 2 * MiB, WS_WO = 8 * MiB, WS_WGU = 10 * MiB, WS_WD = 22 * MiB, WS_SS = 28 * MiB;
constexpr size_t WS_XN = 34 * MiB;
constexpr size_t WS_MIX = 194 * MiB;
constexpr size_t WS_QKV = 354 * MiB;
constexpr size_t WS_END = 834 * MiB;
constexpr int RING_BYTES = 131072, LDS_BYTES = 147456;

#define LAS __attribute__((address_space(3)))
typedef unsigned short bf16_t;
typedef short bf16x8 __attribute__((ext_vector_type(8)));
typedef short v4i16 __attribute__((ext_vector_type(4)));
typedef float f32x4 __attribute__((ext_vector_type(4)));
typedef unsigned u32x4 __attribute__((ext_vector_type(4)));
typedef unsigned u32x2 __attribute__((ext_vector_type(2)));

typedef float f32x2_t __attribute__((ext_vector_type(2))); typedef __bf16 bf16x2_t __attribute__((ext_vector_type(2)));
__device__ __forceinline__ unsigned cvtpk(float lo, float hi) { const f32x2_t v = {lo, hi}; const bf16x2_t b = __builtin_convertvector(v, bf16x2_t); return __builtin_bit_cast(unsigned, b); }
__device__ __forceinline__ float wave_sum(float v) {
#pragma unroll
    for (int o = 1; o < 64; o <<= 1) v += __shfl_xor(v, o);
    return v;
}

namespace att {
constexpr int VRS = 160, VBUF = 32 * VRS, KRS = 144, KBUF = 32 * KRS, WBUF = VBUF + KBUF;
constexpr int LDS_TAB = 8 * WBUF + 256, LDS_EXCH = 98304, LDS_GAIN = 106496;
constexpr float RESCALE_THR = 6.0f;
constexpr float M_INIT = -4096.f;
typedef float f32x2 __attribute__((ext_vector_type(2)));
struct Tile { f32x4 o[4]; float la; float m; };
__device__ __forceinline__ f32x4 mfma16(bf16x8 a, bf16x8 b, f32x4 c) { return __builtin_amdgcn_mfma_f32_16x16x32_bf16(a, b, c, 0, 0, 0); }
__device__ __forceinline__ v4i16 trd(LAS const unsigned char* p) { return __builtin_amdgcn_ds_read_tr16_b64_v4i16((LAS v4i16*)p); }
__device__ __forceinline__ void tile_init(Tile& t) {
#pragma unroll
    for (int dt = 0; dt < 4; ++dt) t.o[dt] = (f32x4){0.f, 0.f, 0.f, 0.f};
    t.la = 0.f; t.m = M_INIT;
}
__device__ __forceinline__ bf16x8 tile_softmax(Tile& t, float (&x)[8]) {
    float mx = fmaxf(fmaxf(fmaxf(x[0], x[1]), fmaxf(x[2], x[3])), fmaxf(fmaxf(x[4], x[5]), fmaxf(x[6], x[7])));
    { const auto r16 = __builtin_amdgcn_permlane16_swap(__float_as_uint(mx), __float_as_uint(mx), false, false); mx = fmaxf(__uint_as_float(r16[0]), __uint_as_float(r16[1])); }
    { const auto r32 = __builtin_amdgcn_permlane32_swap(__float_as_uint(mx), __float_as_uint(mx), false, false); mx = fmaxf(__uint_as_float(r32[0]), __uint_as_float(r32[1])); }
    if (__any(mx > RESCALE_THR)) {
        const float d = fmaxf(mx, 0.f), alpha = __builtin_amdgcn_exp2f(-d); t.m += d;
#pragma unroll
        for (int i = 0; i < 8; ++i) x[i] -= d;
#pragma unroll
        for (int dt = 0; dt < 4; ++dt) t.o[dt] = t.o[dt] * alpha;
        t.la = t.la * alpha;
    }
    float p[8];
#pragma unroll
    for (int i = 0; i < 8; ++i) p[i] = __builtin_amdgcn_exp2f(x[i]);
    t.la += ((p[0] + p[1]) + (p[2] + p[3])) + ((p[4] + p[5]) + (p[6] + p[7]));
    u32x4 pw; pw.x = cvtpk(p[0], p[1]); pw.y = cvtpk(p[2], p[3]); pw.z = cvtpk(p[4], p[5]); pw.w = cvtpk(p[6], p[7]);
    return __builtin_bit_cast(bf16x8, pw);
}
__device__ __forceinline__ void tile_pv(Tile& t, const bf16x8 pf, const bf16x8 (&vf)[4]) {
#pragma unroll
    for (int dt = 0; dt < 4; ++dt) t.o[dt] = mfma16(vf[dt], pf, t.o[dt]);
}
__device__ __forceinline__ void read_vfrags(bf16x8 (&vf)[4], LAS const unsigned char* vp) {
#pragma unroll
    for (int dt = 0; dt < 4; ++dt) { const v4i16 lo = trd(vp + dt * 32), hi = trd(vp + 16 * VRS + dt * 32);
        vf[dt] = (bf16x8){lo[0], lo[1], lo[2], lo[3], hi[0], hi[1], hi[2], hi[3]}; }
}
template <int SH, int NT, int QS, int CS, int NP> __device__ __forceinline__ void dil_run(Tile (&tl)[NT], const bf16x8 (&qf)[NT][2], const bf16_t* qkv_seq, int h, int T, int qb, float sld, LAS unsigned char* vbuf, int lane) {
    constexpr int D = 1 << SH;
    const int n = lane & 15, g = lane >> 4;
    const int lo_t = 64 - (qb >> SH), hi_t = 64 + ((T - 1 - qb) >> SH);
    float relb[NT], rlo[NT], rhi[NT];
#pragma unroll
    for (int c = 0; c < NT; ++c) { const int off = 64 + CS * c + QS * n; relb[c] = (float)(4 * g - off); rlo[c] = (float)max(-64, lo_t - off); rhi[c] = (float)min(64, hi_t - off); }
    const char* kvbase = (const char*)(qkv_seq + 2048 + h * 64 + (lane & 7) * 8);
    const int vrow = lane >> 3;
    LAS unsigned char* vw = vbuf + vrow * VRS + (lane & 7) * 16;
    LAS unsigned char* kw = vbuf + VBUF + vrow * KRS + (lane & 7) * 16;
    LAS const unsigned char* vp = vbuf + (4 * g + (n >> 2)) * VRS + (n & 3) * 8;
    LAS const unsigned char* kr = vbuf + VBUF + n * KRS + g * 16;
    u32x4 kA[4], vA[4];
#define DIL_LOAD(p, KN, VN) do { \
    _Pragma("unroll") for (int i = 0; i < 4; ++i) { const int tok = min(max(qb + D * (32 * (p) + vrow + 8 * i - 64), 0), T - 1); \
        const char* rp = kvbase + (unsigned)tok * (unsigned)(QKVW * 2); KN[i] = *(const u32x4*)rp; VN[i] = *(const u32x4*)(rp + 1024); } } while (0)
#define DIL_STEP(p, KN, VN) do { \
        _Pragma("unroll") for (int i = 0; i < 4; ++i) *(LAS u32x4*)(kw + 8 * i * KRS) = KN[i]; \
        bf16x8 kf[2][2]; \
        _Pragma("unroll") for (int tt = 0; tt < 2; ++tt) { kf[tt][0] = *(LAS const bf16x8*)(kr + tt * 16 * KRS); kf[tt][1] = *(LAS const bf16x8*)(kr + tt * 16 * KRS + 64); } \
        _Pragma("unroll") for (int i = 0; i < 4; ++i) *(LAS u32x4*)(vw + 8 * i * VRS) = VN[i]; \
        if ((p) + 1 <= p_hi) DIL_LOAD((p) + 1, KN, VN); \
        bf16x8 pf[NT]; bool act[NT]; \
        _Pragma("unroll") for (int c = 0; c < NT; ++c) { \
              \
            act[c] = (CS < 16) || (32 * (p) + 31 >= CS * c && 32 * (p) <= CS * c + 15 * QS + 128); pf[c] = (bf16x8){0, 0, 0, 0, 0, 0, 0, 0}; \
            if (act[c]) { const float nm = -tl[c].m; const f32x4 negm = (f32x4){nm, nm, nm, nm}; f32x4 s[2]; \
            _Pragma("unroll") for (int tt = 0; tt < 2; ++tt) { s[tt] = mfma16(kf[tt][0], qf[c][0], negm); s[tt] = mfma16(kf[tt][1], qf[c][1], s[tt]); } \
            const float relp = relb[c] + (float)(32 * (p)); float x[8]; \
            _Pragma("unroll") for (int tt = 0; tt < 2; ++tt) \
            _Pragma("unroll") for (int r = 0; r < 4; ++r) { const float rel = relp + (float)(16 * tt + r); const float xv = fmaf(fabsf(rel), sld, s[tt][r]); \
                    x[4 * tt + r] = (__builtin_amdgcn_fmed3f(rel, rlo[c], rhi[c]) == rel) ? xv : -INFINITY; } \
            pf[c] = tile_softmax(tl[c], x); } } \
        bf16x8 vf[4]; read_vfrags(vf, vp); \
        _Pragma("unroll") for (int c = 0; c < NT; ++c) if (act[c]) tile_pv(tl[c], pf[c], vf); } while (0)
    const int p_lo = max(0, lo_t >> 5), p_hi = min(NP - 1, hi_t >> 5);
    DIL_LOAD(p_lo, kA, vA);
#pragma unroll 1
    for (int p = p_lo; p <= p_hi; ++p) DIL_STEP(p, kA, vA);
#undef DIL_STEP
#undef DIL_LOAD
}

__device__ __forceinline__ void na_quad(Tile (&tl)[4], const bf16x8 (&qf)[4][2], const bf16_t* qkv_seq, int h, int r, int rows, int nb, LAS const unsigned char* rpbh, LAS unsigned char* vbuf, int lane) {
    const int n = lane & 15, g = lane >> 4;
    const int qcol = 16 * nb + n, kstart = min(max(16 * nb - 8, 0), 32), wstart = min(max(qcol - 8, 0), 48), wofs = wstart - kstart, cb = kstart - qcol + 15 + 4 * g;
    const int rs0 = min(max(r - 4, 0), rows - 8);
    int boff[8];
#pragma unroll
    for (int tt = 0; tt < 2; ++tt)
#pragma unroll
        for (int q = 0; q < 4; ++q) { const int kc = 16 * tt + 4 * g + q; boff[4 * tt + q] = ((unsigned)(kc - wofs) < 16u) ? 4 * (cb + 16 * tt + q) : 4 * 31; }
    const char* kvbase = (const char*)(qkv_seq + 512 + h * 64 + (lane & 7) * 8);
    const int vrow = lane >> 3;
    LAS unsigned char* vw = vbuf + vrow * VRS + (lane & 7) * 16;
    LAS unsigned char* kw = vbuf + VBUF + vrow * KRS + (lane & 7) * 16;
    LAS const unsigned char* vp = vbuf + (4 * g + (n >> 2)) * VRS + (n & 3) * 8;
    LAS const unsigned char* kfr = vbuf + VBUF + n * KRS + g * 16;
    u32x4 kA[4], vA[4];
#define NA_LOAD(kr, KN, VN) do { const int tb = min(rs0 + (kr), rows - 1) * 64 + kstart + vrow; \
    _Pragma("unroll") for (int i = 0; i < 4; ++i) { const char* rp = kvbase + (unsigned)(tb + 8 * i) * (unsigned)(QKVW * 2); KN[i] = *(const u32x4*)rp; VN[i] = *(const u32x4*)(rp + 1024); } } while (0)
#define NA_STEP(kr, KN, VN) do { \
        _Pragma("unroll") for (int i = 0; i < 4; ++i) *(LAS u32x4*)(kw + 8 * i * KRS) = KN[i]; \
        bf16x8 kf[2][2]; \
        _Pragma("unroll") for (int tt = 0; tt < 2; ++tt) { kf[tt][0] = *(LAS const bf16x8*)(kfr + tt * 16 * KRS); kf[tt][1] = *(LAS const bf16x8*)(kfr + tt * 16 * KRS + 64); } \
        _Pragma("unroll") for (int i = 0; i < 4; ++i) *(LAS u32x4*)(vw + 8 * i * VRS) = VN[i]; \
        if ((kr) + 1 < 11) NA_LOAD((kr) + 1, KN, VN); \
        bf16x8 pf[4]; bool act[4]; \
        _Pragma("unroll") for (int c = 0; c < 4; ++c) { const int rsc = min(max(r + c - 4, 0), rows - 8), kk = rs0 + (kr) - rsc; act[c] = (unsigned)kk < 8u; pf[c] = (bf16x8){0, 0, 0, 0, 0, 0, 0, 0}; \
            if (act[c]) {                             \
            const float nm = -tl[c].m; const f32x4 negm = (f32x4){nm, nm, nm, nm}; f32x4 s[2]; \
            _Pragma("unroll") for (int tt = 0; tt < 2; ++tt) { s[tt] = mfma16(kf[tt][0], qf[c][0], negm); s[tt] = mfma16(kf[tt][1], qf[c][1], s[tt]); } \
            LAS const unsigned char* bt = rpbh + (rs0 + (kr) - (r + c) + 7) * 128; float x[8]; \
            _Pragma("unroll") for (int i = 0; i < 8; ++i) x[i] = s[i >> 2][i & 3] + *(LAS const float*)(bt + boff[i]); \
            pf[c] = tile_softmax(tl[c], x); } } \
        bf16x8 vf[4]; read_vfrags(vf, vp); \
        _Pragma("unroll") for (int c = 0; c < 4; ++c) if (act[c]) tile_pv(tl[c], pf[c], vf); } while (0)
    NA_LOAD(0, kA, vA);
#pragma unroll 1
    for (int kr = 0; kr < 11; ++kr) NA_STEP(kr, kA, vA);
#undef NA_STEP
#undef NA_LOAD
}

__device__ __forceinline__ void regroup(Tile (&tl)[4], LAS unsigned char* buf, int lane) {
    const int n = lane & 15, g = lane >> 4;
    const int qs0 = (n >> 2) * 16 + 4 * (n & 3);
#pragma unroll
    for (int hf = 0; hf < 2; ++hf) {
#pragma unroll
        for (int c = 0; c < 4; ++c)
#pragma unroll
            for (int d2 = 0; d2 < 2; ++d2) *(LAS f32x4*)(buf + (qs0 + c) * 128 + (d2 * 16 + 4 * g) * 4) = tl[c].o[2 * hf + d2];
        if (hf == 0) {
#pragma unroll
            for (int c = 0; c < 4; ++c) { *(LAS float*)(buf + 8192 + ((qs0 + c) * 4 + g) * 4) = tl[c].la; *(LAS float*)(buf + 9216 + (qs0 + c) * 4) = tl[c].m; }
        }
#pragma unroll
        for (int c = 0; c < 4; ++c)
#pragma unroll
            for (int d2 = 0; d2 < 2; ++d2) tl[c].o[2 * hf + d2] = *(LAS const f32x4*)(buf + (c * 16 + n) * 128 + (d2 * 16 + 4 * g) * 4);
        if (hf == 0) {
#pragma unroll
            for (int c = 0; c < 4; ++c) { tl[c].la = *(LAS const float*)(buf + 8192 + ((c * 16 + n) * 4 + g) * 4); tl[c].m = *(LAS const float*)(buf + 9216 + (c * 16 + n) * 4); }
        }
    }
}

__device__ __forceinline__ void finish_tile(Tile& t, LAS float* exch, int h, LAS const float* gainp  , bf16_t* orow, int lane) {
    const int n = lane & 15, g = lane >> 4;
    float l = t.la; l += __shfl_xor(l, 16); l += __shfl_xor(l, 32);
    const float inv = 1.0f / l; float ss = 0.f;
#pragma unroll
    for (int dt = 0; dt < 4; ++dt) { t.o[dt] = t.o[dt] * inv; const f32x4 v = t.o[dt]; ss += (v[0] * v[0] + v[1] * v[1]) + (v[2] * v[2] + v[3] * v[3]); }
    ss += __shfl_xor(ss, 16); ss += __shfl_xor(ss, 32);
    if (g == 0) exch[h * 16 + n] = ss;
    __syncthreads();
    float tot = 0.f;
#pragma unroll
    for (int hh = 0; hh < 8; ++hh) tot += exch[hh * 16 + n];
    const float rinv = 1.0f / sqrtf(tot * (1.0f / 512.0f) + RMS_EPS);
#pragma unroll
    for (int dt = 0; dt < 4; ++dt) { const f32x4 v = t.o[dt] * *(LAS const f32x4*)(gainp + 16 * dt) * rinv; u32x2 w; w.x = cvtpk(v[0], v[1]); w.y = cvtpk(v[2], v[3]); *(u32x2*)(orow + 16 * dt) = w; }
}
__device__ __forceinline__ void load_q(bf16x8 (&qf)[2], const bf16_t* qp) { qf[0] = *(const bf16x8*)qp; qf[1] = *(const bf16x8*)(qp + 32); }
#define ATT_PATTERN_FENCE() asm volatile("s_waitcnt vmcnt(0)\n\tbuffer_inv sc1\n\ts_waitcnt vmcnt(0)" ::: "memory")

#ifndef REP_DIL
#define REP_DIL 1
#endif
#ifndef REP_NA
#define REP_NA 1
#endif
__device__ __forceinline__ void attn_phase(LAS unsigned char* lds, const bf16_t* qkv, bf16_t* mix, const float* rpb, const float* g_na, const float* g_dil, int vcu, int G, const int wave) {
    int lane_ = __builtin_amdgcn_mbcnt_hi(~0u, __builtin_amdgcn_mbcnt_lo(~0u, 0u)); asm volatile("" : "+v"(lane_)); const int lane = lane_ & 63, h = wave, tid = h * 64 + lane, n = lane & 15, g = lane >> 4;
    LAS float* tab = (LAS float*)(lds + LDS_TAB);
    { LAS float* gl = (LAS float*)(lds + LDS_GAIN); for (int i = tid; i < 1024; i += 512) gl[i] = (i < 512) ? g_dil[i] : g_na[i - 512]; }
    for (int i = tid; i < 8 * 16 * 32; i += 512) { const int c = i & 31, rr = (i >> 5) & 15, hh = i >> 9; tab[i] = (c < 31 && rr < 15) ? rpb[(hh * 15 + rr) * 31 + c] * LOG2E : -INFINITY; }
    __syncthreads();
    LAS unsigned char* vbuf = lds + h * WBUF;
    LAS float* exch = (LAS float*)(lds + LDS_EXCH);
    int par = 0;
    {
        const float sl2 = -LOG2E * __builtin_amdgcn_exp2f(-(float)(h + 1));
        for (int rep = 0; rep < REP_DIL; ++rep)
        for (int item = vcu; item < 1280; item += G) {
            const int jr = item / G, u0r = (item - jr * G) >> 2; const int unit = (G == 256) ? jr * 64 + (u0r & ~7) + ((u0r + jr) & 7) : (item >> 2); const int pg = item & 3;
            int sb, T, u0;
            if (unit < 64) { sb = (unit >> 4) * 4096; T = 4096; u0 = (unit & 15) * 256; } else { const int uu = unit - 64; sb = NPROMPT + (uu >> 3) * 2048; T = 2048; u0 = (uu & 7) * 256; }
            const bf16_t* qkv_seq = qkv + (size_t)sb * QKVW;
            const bf16_t* qcolp = qkv_seq + 1536 + h * 64 + 8 * g;
            {
                const int ub = u0 + pg; Tile tl[4]; bf16x8 qf[4][2];
#pragma unroll
                for (int c = 0; c < 4; ++c) { tile_init(tl[c]); load_q(qf[c], qcolp + (size_t)(ub + 4 * c + 16 * n) * QKVW); }
#pragma unroll
                for (int c = 0; c < 4; ++c) { Tile t1[1]; bf16x8 q1[1][2]; t1[0] = tl[c]; q1[0][0] = qf[c][0]; q1[0][1] = qf[c][1];
                    dil_run<4, 1, 1, 0, 5>(t1, q1, qkv_seq, h, T, ub + 4 * c, sl2 * 16.0f, vbuf, lane);
                    tl[c] = t1[0]; }
#pragma unroll
                for (int c = 0; c < 4; ++c) load_q(qf[c], qcolp + (size_t)(ub + 64 * c + 4 * n) * QKVW);
                regroup(tl, vbuf, lane);
                dil_run<2, 4, 1, 16, 6>(tl, qf, qkv_seq, h, T, ub, sl2 * 4.0f, vbuf, lane);
                dil_run<0, 4, 4, 64, 12>(tl, qf, qkv_seq, h, T, ub, sl2, vbuf, lane);
#pragma unroll
                for (int c = 0; c < 4; ++c) {
                    int lane2 = lane; asm volatile("" : "+v"(lane2));
                    const int n2 = lane2 & 15, g2 = lane2 >> 4;
                    finish_tile(tl[c], exch + par * 128, h, (LAS const float*)(lds + LDS_GAIN) + h * 64 + 4 * g2, mix + (size_t)(sb + ub + 64 * c + 4 * n2) * DM + 512 + h * 64 + 4 * g2, lane2);
                    par ^= 1; }
            }
        }
    }
    {
        int lane_n = __builtin_amdgcn_mbcnt_hi(~0u, __builtin_amdgcn_mbcnt_lo(~0u, 0u)); asm volatile("" : "+v"(lane_n)); const int lane = lane_n & 63, n = lane & 15, g = lane >> 4;
        LAS const unsigned char* rpbh = (LAS const unsigned char*)(tab + h * (16 * 32));
        for (int rep = 0; rep < REP_NA; ++rep)
        for (int item = vcu; item < 1280; item += G) {
            const int qd = item >> 2, nb = item & 3;
            int sb, rows, r;
            if (qd < 64) { sb = (qd >> 4) * 4096; rows = 64; r = (qd & 15) * 4; } else { const int ii = qd - 64; sb = NPROMPT + (ii >> 3) * 2048; rows = 32; r = (ii & 7) * 4; }
            const bf16_t* qkv_seq = qkv + (size_t)sb * QKVW;
            Tile tl[4]; bf16x8 qf[4][2];
#pragma unroll
            for (int c = 0; c < 4; ++c) { tile_init(tl[c]); load_q(qf[c], qkv_seq + (size_t)((r + c) * 64 + 16 * nb + n) * QKVW + h * 64 + 8 * g); }
            na_quad(tl, qf, qkv_seq, h, r, rows, nb, rpbh, vbuf, lane);
#pragma unroll
            for (int c = 0; c < 4; ++c) { int lane2 = lane; asm volatile("" : "+v"(lane2)); const int n2 = lane2 & 15, g2 = lane2 >> 4;
                finish_tile(tl[c], exch + par * 128, h, (LAS const float*)(lds + LDS_GAIN) + 512 + h * 64 + 4 * g2, mix + (size_t)(sb + (r + c) * 64 + 16 * nb + n2) * DM + h * 64 + 4 * g2, lane2); par ^= 1; }
        }
    }
    __syncthreads();
}
}

__device__ __forceinline__ void transpose_item(const float* W, int K, int N, bf16_t* WT, int k0, int n0, int dst_row0, const float* kgain, float sn, LAS float* scr, int lane) {
#pragma unroll
    for (int i = 0; i < 32; ++i) { const int kk = 2 * i + (lane >> 5); float v = W[(size_t)(k0 + kk) * N + n0 + (lane & 31)] * sn; if (kgain) v *= kgain[k0 + kk]; scr[kk * 33 + (lane & 31)] = v; }
    asm volatile("s_waitcnt lgkmcnt(0)" ::: "memory");
    const int c = lane & 7;
#pragma unroll
    for (int j = 0; j < 4; ++j) { const int nn = (lane >> 3) + 8 * j; const LAS float* s = scr + (8 * c) * 33 + nn;
        u32x4 o; o.x = cvtpk(s[0 * 33], s[1 * 33]); o.y = cvtpk(s[2 * 33], s[3 * 33]); o.z = cvtpk(s[4 * 33], s[5 * 33]); o.w = cvtpk(s[6 * 33], s[7 * 33]);
        *(u32x4*)(WT + (size_t)(dst_row0 + nn) * K + k0 + 8 * c) = o; }
    asm volatile("s_waitcnt lgkmcnt(0)" ::: "memory");
}
template <bool TOBF> __device__ __forceinline__ void rms_row(const float* xrow, const float* gain, void* orow, int lane) {
    const f32x4* xr = (const f32x4*)xrow + lane; const f32x4* gr = (const f32x4*)gain + lane;
    f32x4 v[4]; float s = 0.f;
#pragma unroll
    for (int j = 0; j < 4; ++j) { v[j] = xr[64 * j]; s += (v[j][0] * v[j][0] + v[j][1] * v[j][1]) + (v[j][2] * v[j][2] + v[j][3] * v[j][3]); }
    const float rinv = 1.0f / sqrtf(wave_sum(s) * (1.0f / 1024.0f) + RMS_EPS);
#pragma unroll
    for (int j = 0; j < 4; ++j) { const f32x4 o = v[j] * rinv * gr[64 * j];
        if (TOBF) { u32x2 w; w.x = cvtpk(o[0], o[1]); w.y = cvtpk(o[2], o[3]); ((u32x2*)orow)[64 * j + lane] = w; }
        else ((f32x4*)orow)[64 * j + lane] = o; }
}

template <bool TOBF> __device__ __forceinline__ void rms_rows(const float* p0, const float* p1, const float* gain, void* obase, int gw, int NGW, int lane) {
    f32x4 gr[4], a[4], b[4], c[4];
#pragma unroll
    for (int j = 0; j < 4; ++j) gr[j] = ((const f32x4*)gain)[64 * j + lane];
#define RR_LOAD(dst, mm) do { const int m_ = min((mm), MROWS - 1); const f32x4* xr_ = (const f32x4*)(m_ < NPROMPT ? p0 + (size_t)m_ * DM : p1 + (size_t)(m_ - NPROMPT) * DM) + lane; \
    _Pragma("unroll") for (int j = 0; j < 4; ++j) dst[j] = xr_[64 * j]; } while (0)
    RR_LOAD(a, gw); RR_LOAD(b, gw + NGW);
    for (int m = gw; m < MROWS; m += NGW) {
        RR_LOAD(c, m + 2 * NGW);
        float s = 0.f;
#pragma unroll
        for (int j = 0; j < 4; ++j) s += (a[j][0] * a[j][0] + a[j][1] * a[j][1]) + (a[j][2] * a[j][2] + a[j][3] * a[j][3]);
        const float rinv = 1.0f / sqrtf(wave_sum(s) * (1.0f / 1024.0f) + RMS_EPS);
#pragma unroll
        for (int j = 0; j < 4; ++j) { const f32x4 o = a[j] * rinv * gr[j];
            if (TOBF) { u32x2 w; w.x = cvtpk(o[0], o[1]); w.y = cvtpk(o[2], o[3]); ((u32x2*)obase)[(size_t)m * 256 + 64 * j + lane] = w; }
            else ((f32x4*)obase)[(size_t)m * 256 + 64 * j + lane] = o; }
#pragma unroll
        for (int j = 0; j < 4; ++j) { a[j] = b[j]; b[j] = c[j]; }
    }
#undef RR_LOAD
}

__device__ __forceinline__ void final_rows(const bf16_t* y, const float* ss, const float* gain, float* out, int gw, int NGW, int lane) {
    f32x4 gr[4]; u32x2 a[4], b[4], c[4]; float sa, sb, sc;
#pragma unroll
    for (int j = 0; j < 4; ++j) gr[j] = ((const f32x4*)gain)[64 * j + lane];
#define FR_LOAD(dst, sd, mm) do { const int m_ = min((mm), MROWS - 1); const u32x2* yr_ = (const u32x2*)(y + (size_t)m_ * DM) + lane; \
    _Pragma("unroll") for (int j = 0; j < 4; ++j) dst[j] = yr_[64 * j]; sd = ss[(size_t)m_ * 16 + (lane & 15)]; } while (0)
    FR_LOAD(a, sa, gw); FR_LOAD(b, sb, gw + NGW);
    for (int m = gw; m < MROWS; m += NGW) {
        FR_LOAD(c, sc, m + 2 * NGW);
        float t = sa; t += __shfl_xor(t, 1); t += __shfl_xor(t, 2); t += __shfl_xor(t, 4); t += __shfl_xor(t, 8);
        const float rinv = 1.0f / sqrtf(t * (1.0f / 1024.0f) + RMS_EPS);
#pragma unroll
        for (int j = 0; j < 4; ++j) { const f32x4 v = (f32x4){__uint_as_float(a[j].x << 16), __uint_as_float(a[j].x & 0xffff0000u), __uint_as_float(a[j].y << 16), __uint_as_float(a[j].y & 0xffff0000u)};
            ((f32x4*)out)[(size_t)m * 256 + 64 * j + lane] = v * rinv * gr[j]; }
#pragma unroll
        for (int j = 0; j < 4; ++j) { a[j] = b[j]; b[j] = c[j]; }
        sa = sb; sb = sc;
    }
#undef FR_LOAD
}

#define XB_TMO      128
#define XB_XCNT(j)  (256  + 64 * (j))
#define XB_XSUB(j)  (1280 + 64 * (j))
#define XB_XGEN(j)  (2304 + 64 * (j))
#define XB_TOP      3328
#define XB_TOPGEN   3392
#define XCD_BAR_WORDS 3456
#define XB_SPIN_CAP (1u << 18)

__device__ __forceinline__ unsigned xb_ld(unsigned* p)              { return __hip_atomic_load(p, __ATOMIC_RELAXED, __HIP_MEMORY_SCOPE_AGENT); }
__device__ __forceinline__ unsigned xb_add(unsigned* p, unsigned v) { return __hip_atomic_fetch_add(p, v, __ATOMIC_RELAXED, __HIP_MEMORY_SCOPE_AGENT); }
__device__ __forceinline__ unsigned xb_xcc_id() { return (unsigned)__builtin_amdgcn_s_getreg((3 << 11) | 20) & 0xFu; }
#define XB_SPIN(cond, bar) do { unsigned _sp = 0; while (cond) { __builtin_amdgcn_s_sleep(1); \
    if ((++_sp & 255u) == 0u) { if (xb_ld(&(bar)[XB_TMO])) break; if (_sp > XB_SPIN_CAP) { atomicAdd(&(bar)[XB_TMO], 1u); break; } } } } while (0)

struct XcdBarrier {
    unsigned* bar; unsigned x;
    volatile LAS unsigned* st;
};

__device__ __forceinline__ XcdBarrier xcd_barrier_post(unsigned* bar, volatile LAS unsigned* st) {
    XcdBarrier b; b.bar = bar; b.x = xb_xcc_id(); b.st = st;
    if (threadIdx.x == 0) (void)xb_add(&bar[XB_XCNT(b.x)], 1u);
    return b;
}
__device__ __forceinline__ void xcd_barrier_complete(unsigned* bar, unsigned x, unsigned& nloc, unsigned& nx) {
    const unsigned G = gridDim.x * gridDim.y * gridDim.z;
    unsigned sum, cnt, mine, sp = 0u;
    for (;;) {
        sum = 0u; cnt = 0u; mine = 0u;
#pragma unroll
        for (unsigned j = 0; j < 16; ++j) { const unsigned c = xb_ld(&bar[XB_XCNT(j)]); sum += c; cnt += (c > 0u) ? 1u : 0u; mine = (j == x) ? c : mine; }
        if (sum == G) break;
        __builtin_amdgcn_s_sleep(1);
        if ((++sp & 255u) == 0u) { if (xb_ld(&bar[XB_TMO])) break; if (sp > XB_SPIN_CAP) { atomicAdd(&bar[XB_TMO], 1u); break; } }
    }
    nloc = mine > 0u ? mine : 1u; nx = cnt > 0u ? cnt : 1u;
}

__device__ __forceinline__ void xcd_barrier(const XcdBarrier& b, const int wave) {
    asm volatile("s_waitcnt vmcnt(0)" ::: "memory");
    __syncthreads();
    if (wave == 0 && __builtin_amdgcn_mbcnt_hi(~0u, __builtin_amdgcn_mbcnt_lo(~0u, 0u)) == 0u) {
        unsigned* bar = b.bar;
        __builtin_amdgcn_s_waitcnt(0);
        unsigned nloc = b.st[0], nx = b.st[1];
        if (nloc == 0u) { xcd_barrier_complete(bar, b.x, nloc, nx); b.st[0] = nloc; b.st[1] = nx; }
        const unsigned old = xb_add(&bar[XB_XSUB(b.x)], 1u);
        const unsigned gen = old / nloc;
        if (old + 1u == (gen + 1u) * nloc) {
            __builtin_amdgcn_fence(__ATOMIC_RELEASE, "agent");
            asm volatile("s_waitcnt vmcnt(0)" ::: "memory");
            const unsigned og = xb_add(&bar[XB_TOP], 1u);
            const unsigned tg = og / nx;
            if (og + 1u == (tg + 1u) * nx) xb_add(&bar[XB_TOPGEN], 1u);
            else XB_SPIN(xb_ld(&bar[XB_TOPGEN]) == tg, bar);
            __builtin_amdgcn_fence(__ATOMIC_ACQUIRE, "agent");
            xb_add(&bar[XB_XGEN(b.x)], 1u);
            asm volatile("s_waitcnt vmcnt(0)" ::: "memory");
        } else {
            XB_SPIN(xb_ld(&bar[XB_XGEN(b.x)]) == gen, bar);
            __builtin_amdgcn_fence(__ATOMIC_ACQUIRE, "agent");
            asm volatile("s_waitcnt vmcnt(0)" ::: "memory");
        }
    }
    __syncthreads();
}

struct Args { const float* in[13]; float* out; unsigned char* ws; };

#define GRID_SYNC() do { asm volatile("s_waitcnt vmcnt(0)" ::: "memory"); grid.sync(); asm volatile("buffer_inv sc1\n\ts_waitcnt vmcnt(0)" ::: "memory"); } while (0)
#define XSYNC() xcd_barrier(xbar, wave)
__global__ void __launch_bounds__(512, 2) hymba_fwd(Args a) {
    extern __shared__ __attribute__((aligned(16))) unsigned char lds_raw[];
    cg::grid_group grid = cg::this_grid();
    LAS unsigned char* lds = (LAS unsigned char*)lds_raw;
    const int wave = __builtin_amdgcn_readfirstlane((int)threadIdx.x >> 6);
    volatile LAS unsigned* xst = (volatile LAS unsigned*)(lds + RING_BYTES + 64);
    if (threadIdx.x < 2) xst[threadIdx.x] = 0u;
    __syncthreads();
    const XcdBarrier xbar = xcd_barrier_post((unsigned*)(a.ws + 4096), xst);
    const int G = gridDim.x, bx = blockIdx.x, vcu = (G % 8 == 0) ? (bx % 8) * (G / 8) + bx / 8 : bx;
    unsigned char* ws = a.ws;
    bf16_t* Win_t = (bf16_t*)(ws + WS_WIN); bf16_t* Wo_t = (bf16_t*)(ws + WS_WO); bf16_t* Wgu_t = (bf16_t*)(ws + WS_WGU); bf16_t* Wd_t = (bf16_t*)(ws + WS_WD);
    float* SS = (float*)(ws + WS_SS); bf16_t* XN = (bf16_t*)(ws + WS_XN); bf16_t* MIX = (bf16_t*)(ws + WS_MIX); bf16_t* QKV = (bf16_t*)(ws + WS_QKV); bf16_t* HB = (bf16_t*)(ws + WS_QKV);
    const float* xp = a.in[0]; const float* xs = a.in[1];
    const int gw = vcu * 8 + wave, NGW = G * 8;

#ifndef REP_P0
#define REP_P0 1
#endif
    for (int rep0 = 0; rep0 < REP_P0; ++rep0) {
        int lane = __builtin_amdgcn_mbcnt_hi(~0u, __builtin_amdgcn_mbcnt_lo(~0u, 0u)); asm volatile("" : "+v"(lane)); lane &= 63;
        LAS float* scr = (LAS float*)(lds + wave * 16384);
        constexpr int I_IN = 16 * 96, I_O = 16 * 32, I_G = 16 * 88, I_D = 44 * 32, NITEMS = I_IN + I_O + 2 * I_G + I_D;
        for (int it = gw; it < NITEMS; it += NGW) {
            int r = it;
            if (r < I_IN) { const int kb = r / 96, nb = r % 96, n0 = 32 * nb; const float sn = (n0 < 512 || (n0 >= 1536 && n0 < 2048)) ? 0.125f * LOG2E : 1.0f;
                transpose_item(a.in[2], 1024, QKVW, Win_t, 64 * kb, n0, n0, nullptr, sn, scr, lane); continue; } r -= I_IN;
            if (r < I_O) { const int kb = r / 32, nb = r % 32; transpose_item(a.in[7], 1024, 1024, Wo_t, 64 * kb, 32 * nb, 32 * nb, nullptr, 1.0f, scr, lane); continue; } r -= I_O;
            if (r < 2 * I_G) { const int up = r >= I_G ? 1 : 0; if (up) r -= I_G; const int kb = r / 88, nb = r % 88, n0 = 32 * nb;
                transpose_item(up ? a.in[10] : a.in[9], 1024, DFF, Wgu_t, 64 * kb, n0, (n0 >> 7) * 256 + (n0 & 127) + up * 128, a.in[8], 1.0f, scr, lane); continue; } r -= 2 * I_G;
            { const int kb = r / 32, nb = r % 32; transpose_item(a.in[11], DFF, 1024, Wd_t, 64 * kb, 32 * nb, 32 * nb, nullptr, 1.0f, scr, lane); }
        }
        rms_rows<true>(xp, xs, a.in[4], XN, gw, NGW, lane);
    }
    if (a.out == nullptr) GRID_SYNC();
    XSYNC();
#ifdef REP_SYNC
    for (int rs_ = 0; rs_ < REP_SYNC; ++rs_) GRID_SYNC();
#endif
    {
        pg8::Gemm g{XN, Win_t, MROWS, QKVW, 1024}; pg8::StaticOrder S; S.init(MROWS, QKVW, G, bx);
        pg8::EpiStoreBf16 E{QKV, QKVW};
        pg8::gemm_phase<pg8::EpiStoreBf16, pg8::StaticOrder, true, true>(lds, g, S, E, wave);
#ifdef REP_P1
        pg8::gemm_phase<pg8::EpiStoreBf16, pg8::StaticOrder, true, true>(lds, g, S, E, wave);
#endif
    }
    XSYNC();
    att::attn_phase(lds, QKV, MIX, a.in[3], a.in[5], a.in[6], vcu, G, wave);
    XSYNC();
    {
        pg8::Gemm g{MIX, Wo_t, MROWS, 1024, 1024}; pg8::StaticOrder S; S.init(MROWS, 1024, G, bx);
        pg8::EpiResid<true> E{xp, xs, NPROMPT, nullptr, XN, SS};
        pg8::gemm_phase<pg8::EpiResid<true>, pg8::StaticOrder, true, true>(lds, g, S, E, wave);
#ifdef REP_P3
        pg8::gemm_phase<pg8::EpiResid<true>, pg8::StaticOrder, true, true>(lds, g, S, E, wave);
#endif
    }
    XSYNC();
    {
        pg8::Gemm g{XN, Wgu_t, MROWS, GUW, 1024}; pg8::StaticOrder S; S.init(MROWS, GUW, G, bx);
        pg8::EpiSwiglu E{HB, DFF, SS, (LAS float*)(lds + RING_BYTES + 1024), -1};
        pg8::gemm_phase<pg8::EpiSwiglu, pg8::StaticOrder, true, true>(lds, g, S, E, wave);
#ifdef REP_P4
        pg8::gemm_phase<pg8::EpiSwiglu, pg8::StaticOrder, true, true>(lds, g, S, E, wave);
#endif
    }
    XSYNC();
    {
        pg8::Gemm g{HB, Wd_t, MROWS, 1024, DFF}; pg8::StaticOrder S; S.init(MROWS, 1024, G, bx);
        pg8::EpiResid<false> E{nullptr, nullptr, 0, XN, MIX, SS};
        pg8::gemm_phase<pg8::EpiResid<false>, pg8::StaticOrder, true, true>(lds, g, S, E, wave);
    }
    XSYNC();
    { int l6 = __builtin_amdgcn_mbcnt_hi(~0u, __builtin_amdgcn_mbcnt_lo(~0u, 0u)); asm volatile("" : "+v"(l6)); l6 &= 63;
      final_rows(MIX, SS, a.in[12], a.out, gw, NGW, l6); }
}

extern "C" void kernel_launch(void* const* d_in, const int* in_sizes, int n_in, void* d_out, int out_size, void* d_ws, size_t ws_size, hipStream_t stream) {
    static int grid = 0;
    if (grid == 0) {
        if (n_in != 13 || out_size != MROWS * DM || ws_size < WS_END) { fprintf(stderr, "kernel_launch: unexpected shapes (n_in %d out %d ws %zu)\n", n_in, out_size, ws_size); grid = -1; return; }
        int dev = 0, cus = 0, per_cu = 0;
        hipGetDevice(&dev); hipDeviceGetAttribute(&cus, hipDeviceAttributeMultiprocessorCount, dev);
        if (hipFuncSetAttribute((const void*)hymba_fwd, hipFuncAttributeMaxDynamicSharedMemorySize, LDS_BYTES) != hipSuccess) { fprintf(stderr, "kernel_launch: hipFuncSetAttribute failed\n"); }
        if (hipOccupancyMaxActiveBlocksPerMultiprocessor(&per_cu, (const void*)hymba_fwd, 512, LDS_BYTES) != hipSuccess || per_cu < 1) { fprintf(stderr, "kernel_launch: occupancy query says %d\n", per_cu); per_cu = 1; }
        (void)hipGetLastError();
        grid = cus * per_cu;
    }
    if (grid < 0) return;
    if (hipMemsetAsync(d_ws, 0, 32768, stream) != hipSuccess) { fprintf(stderr, "kernel_launch: memset of the barrier words failed\n"); return; }
    Args a{};
    for (int i = 0; i < 13; ++i) a.in[i] = (const float*)d_in[i];
    a.out = (float*)d_out; a.ws = (unsigned char*)d_ws;
    void* args[] = {&a};
    hipError_t e = hipLaunchCooperativeKernel((const void*)hymba_fwd, dim3(grid), dim3(512), args, LDS_BYTES, stream);
    if (e != hipSuccess) fprintf(stderr, "cooperative launch failed: %s (grid %d)\n", hipGetErrorString(e), grid);
}
```
